# Optimizing an MI355X kernel written in HIP

```python
import jax, jax.numpy as jnp
from jax import lax
import numpy as np

D_MODEL = 1024
BATCH = 2
SEQ = 8192
DEPTH = 4

HEAD_DIM = 64
N_BRANCH = 4
BRANCH_WIDTH = D_MODEL // N_BRANCH
N_META = 16
BLOCK = 128
N_FRONT_PAD = BLOCK - N_META
SB_HEADS = BRANCH_WIDTH // HEAD_DIM
GLA_HEADS = BRANCH_WIDTH // HEAD_DIM
GLA_DK = HEAD_DIM // 2
GLA_DV = HEAD_DIM
GLA_LOW_RANK = 16
GLA_GATE_NORMALIZER = 16.0
ML_HEADS = BRANCH_WIDTH // HEAD_DIM
ML_DH = HEAD_DIM
CONV_WIDTH = 4
RET_HEADS = BRANCH_WIDTH // HEAD_DIM
RET_DH = HEAD_DIM
D_FF = -(-8 * D_MODEL // (3 * 256)) * 256
ROPE_BASE = 10000.0
NORM_EPS = 1e-6

IN_SPLIT_SIZES = (
    BRANCH_WIDTH, BRANCH_WIDTH, BRANCH_WIDTH,
    GLA_HEADS * GLA_DK, GLA_HEADS * GLA_DK, GLA_HEADS * GLA_DV,
    GLA_HEADS * GLA_DV, GLA_LOW_RANK,
    2 * BRANCH_WIDTH, BRANCH_WIDTH, ML_HEADS, ML_HEADS, BRANCH_WIDTH,
    BRANCH_WIDTH, BRANCH_WIDTH, BRANCH_WIDTH, BRANCH_WIDTH,
    N_BRANCH * D_MODEL,
)
IN_WIDTH = sum(IN_SPLIT_SIZES)

kernel_name = "hybrid_sb_gla_mlstm_retnet_block"

F32 = jnp.float32


def _rmsnorm(x, g):
    xf = x.astype(F32)
    y = xf * lax.rsqrt(jnp.mean(xf * xf, axis=-1, keepdims=True) + NORM_EPS)
    return (y * g.astype(F32)).astype(x.dtype)


def _head_rmsnorm(y, g, n_heads):
    b, l, w = y.shape
    yh = y.reshape(b, l, n_heads, w // n_heads)
    yh = yh * lax.rsqrt(jnp.mean(yh * yh, axis=-1, keepdims=True) + NORM_EPS)
    return yh.reshape(b, l, w) * g.astype(F32)


def _to_chunks(t, n_heads):
    b, l, w = t.shape
    return t.reshape(b, l // BLOCK, BLOCK, n_heads, w // n_heads).transpose(0, 3, 1, 2, 4)


def _gate_chunks(t):
    b, l, h = t.shape
    return t.reshape(b, l // BLOCK, BLOCK, h).transpose(0, 3, 1, 2)


def _from_chunks(t):
    b, h, nc, c, d = t.shape
    return t.transpose(0, 2, 3, 1, 4).reshape(b, nc * c, h * d)


def _causal_tril():
    return jnp.tril(jnp.ones((BLOCK, BLOCK), dtype=bool))


def _scan_chunk_states(decay, local):
    decay = jnp.broadcast_to(decay, local.shape)

    def step(state, inp):
        d, u = inp
        return d * state + u, state

    _, prev = lax.scan(step, jnp.zeros_like(local[:, :, 0]),
                       (jnp.moveaxis(decay, 2, 0), jnp.moveaxis(local, 2, 0)))
    return jnp.moveaxis(prev, 0, 2)


def _causal_conv(x, w):
    ch = x.shape[-1]
    return lax.conv_general_dilated(x, w[:, None, :].astype(x.dtype), window_strides=(1,),
                                    padding=[(CONV_WIDTH - 1, 0)],
                                    dimension_numbers=('NWC', 'WIO', 'NWC'),
                                    feature_group_count=ch)


def _rotary(x, positions, n_heads):
    b, l, w = x.shape
    d = w // n_heads
    half = d // 2
    inv_freq = ROPE_BASE ** (-jnp.arange(half, dtype=F32) / half)
    ang = positions.astype(F32)[:, None] * inv_freq[None, :]
    cos, sin = jnp.cos(ang)[:, None, :], jnp.sin(ang)[:, None, :]
    xh = x.reshape(b, l, n_heads, d)
    x1, x2 = xh[..., :half], xh[..., half:]
    return jnp.concatenate([x1 * cos - x2 * sin, x1 * sin + x2 * cos], axis=-1).reshape(b, l, w)


def _stick_breaking(q, k, v, key_valid):
    b, l, w = q.shape
    nb = l // BLOCK
    qh = q.reshape(b, nb, BLOCK, SB_HEADS, HEAD_DIM).transpose(1, 0, 3, 2, 4)
    kh = k.reshape(b, l, SB_HEADS, HEAD_DIM).transpose(0, 2, 1, 3)
    vh = v.reshape(b, l, SB_HEADS, HEAD_DIM).transpose(0, 2, 1, 3)
    key_pos = jnp.arange(l)
    scale = HEAD_DIM ** -0.5

    def one_block(args):
        q_blk, blk = args
        q_pos = blk * BLOCK + jnp.arange(BLOCK)
        z = jnp.einsum('bhqd,bhkd->bhqk', q_blk, kh) * scale
        mask = (key_pos[None, :] < q_pos[:, None]) & key_valid[None, :]
        log_beta = jnp.where(mask, jax.nn.log_sigmoid(z), -jnp.inf)
        log_keep = jnp.where(mask, jax.nn.log_sigmoid(-z), 0.0)
        later = lax.cumsum(log_keep, axis=3, reverse=True) - log_keep
        a = jnp.exp(log_beta + later)
        return jnp.einsum('bhqk,bhkd->bhqd', a, vh)

    out = lax.map(one_block, (qh, jnp.arange(nb)))
    return out.transpose(1, 0, 3, 2, 4).reshape(b, l, w)


def _gla(q, k, v, r, code, w_gate_up, b_gate, norm_g):
    log_a = jax.nn.log_sigmoid(code @ w_gate_up.astype(F32) + b_gate.astype(F32)) / GLA_GATE_NORMALIZER
    qc = _to_chunks(q, GLA_HEADS) * GLA_DK ** -0.5
    kc = _to_chunks(k, GLA_HEADS)
    vc = _to_chunks(v, GLA_HEADS)
    cum = jnp.cumsum(_to_chunks(log_a, GLA_HEADS), axis=3)
    cum_last = cum[:, :, :, -1:, :]
    q_dec = qc * jnp.exp(cum)
    k_dec = kc * jnp.exp(-cum)
    scores = jnp.where(_causal_tril(), jnp.einsum('bhnqd,bhnkd->bhnqk', q_dec, k_dec), 0.0)
    intra = jnp.einsum('bhnqk,bhnke->bhnqe', scores, vc)
    local = jnp.einsum('bhnkd,bhnke->bhnde', kc * jnp.exp(cum_last - cum), vc)
    states = _scan_chunk_states(jnp.swapaxes(jnp.exp(cum_last), -1, -2), local)
    inter = jnp.einsum('bhnqd,bhnde->bhnqe', q_dec, states)
    o = _from_chunks(intra + inter)
    return _head_rmsnorm(o, norm_g, GLA_HEADS) * jax.nn.silu(r)


def _mlstm(qk, v, i_pre, f_pre, o_pre, conv_w, b_i, b_f, norm_g):
    qk = jax.nn.silu(_causal_conv(qk, conv_w))
    q, k = jnp.split(qk, 2, axis=-1)
    qc = _to_chunks(q, ML_HEADS)
    kc = _to_chunks(k, ML_HEADS) * ML_DH ** -0.5
    vc = _to_chunks(v, ML_HEADS)
    log_i = _gate_chunks(i_pre + b_i.astype(F32))
    log_f = jax.nn.log_sigmoid(_gate_chunks(f_pre + b_f.astype(F32)))
    cum_f = jnp.cumsum(log_f, axis=-1)
    cum_last = cum_f[..., -1]
    w_end = cum_last[..., None] - cum_f + log_i
    a_end = jnp.max(w_end, axis=-1)
    p_end = jnp.exp(w_end - a_end[..., None])
    c_loc = jnp.einsum('bhnk,bhnkd,bhnke->bhnde', p_end, kc, vc)
    n_loc = jnp.einsum('bhnk,bhnkd->bhnd', p_end, kc)

    def step(carry, inp):
        c_s, n_s, m_s = carry
        f_l, a_l, c_l, n_l = inp
        m_new = jnp.maximum(f_l + m_s, a_l)
        s_prev = jnp.exp(f_l + m_s - m_new)
        s_loc = jnp.exp(a_l - m_new)
        c_new = s_prev[..., None, None] * c_s + s_loc[..., None, None] * c_l
        n_new = s_prev[..., None] * n_s + s_loc[..., None] * n_l
        return (c_new, n_new, m_new), (c_s, n_s, m_s)

    b, h, nc, c, d = qc.shape
    init = (jnp.zeros((b, h, d, d), F32), jnp.zeros((b, h, d), F32), jnp.zeros((b, h), F32))
    xs = tuple(jnp.moveaxis(t, 2, 0) for t in (cum_last, a_end, c_loc, n_loc))
    _, (c_prev, n_prev, m_prev) = lax.scan(step, init, xs)
    c_prev, n_prev, m_prev = (jnp.moveaxis(t, 0, 2) for t in (c_prev, n_prev, m_prev))
    inter_log = cum_f + m_prev[..., None]
    intra_log = jnp.where(_causal_tril(),
                          cum_f[..., :, None] - cum_f[..., None, :] + log_i[..., None, :], -jnp.inf)
    m_t = jnp.maximum(inter_log, jnp.max(intra_log, axis=-1))
    w_intra = jnp.exp(intra_log - m_t[..., None])
    w_inter = jnp.exp(inter_log - m_t)
    s = jnp.einsum('bhnqd,bhnkd->bhnqk', qc, kc) * w_intra
    num = jnp.einsum('bhnqk,bhnke->bhnqe', s, vc) + w_inter[..., None] * jnp.einsum('bhnqd,bhnde->bhnqe', qc, c_prev)
    den = jnp.sum(s, axis=-1) + w_inter * jnp.einsum('bhnqd,bhnd->bhnq', qc, n_prev)
    h_cell = num / jnp.maximum(jnp.abs(den), jnp.exp(-m_t))[..., None]
    return jax.nn.sigmoid(o_pre) * _head_rmsnorm(_from_chunks(h_cell), norm_g, ML_HEADS)


def _retention(q, k, v, g, positions, norm_g):
    log_gamma = jnp.log1p(-jnp.exp2(-5.0 - jnp.arange(RET_HEADS, dtype=F32)))
    qc = _to_chunks(_rotary(q, positions, RET_HEADS), RET_HEADS)
    kc = _to_chunks(_rotary(k, positions, RET_HEADS), RET_HEADS) * RET_DH ** -0.5
    vc = _to_chunks(v, RET_HEADS)
    pos = jnp.arange(BLOCK, dtype=F32)
    diff = jnp.maximum(pos[:, None] - pos[None, :], 0.0)
    decay_intra = jnp.where(_causal_tril(), jnp.exp(log_gamma[:, None, None] * diff), 0.0)
    scores = jnp.einsum('bhnqd,bhnkd->bhnqk', qc, kc) * decay_intra[None, :, None]
    intra = jnp.einsum('bhnqk,bhnke->bhnqe', scores, vc)
    q_decay = jnp.exp(log_gamma[:, None] * (pos + 1.0))
    k_decay = jnp.exp(log_gamma[:, None] * (BLOCK - 1.0 - pos))
    local = jnp.einsum('bhnkd,bhnke->bhnde', kc * k_decay[None, :, None, :, None], vc)
    states = _scan_chunk_states(jnp.exp(log_gamma * BLOCK)[None, :, None, None, None], local)
    inter = jnp.einsum('bhnqd,bhnde->bhnqe', qc * q_decay[None, :, None, :, None], states)
    y = _from_chunks(intra + inter)
    return jax.nn.silu(g) * _head_rmsnorm(y, norm_g, RET_HEADS)


def _hybrid_layer(h, valid, positions, g_mix_pre, g_mix_post, g_ffn_pre, g_ffn_post, w_in,
                  gla_w_gate_up, gla_b_gate, gla_norm, ml_conv, ml_b_i, ml_b_f, ml_norm, ret_norm,
                  w_branch, b_merge, w_out, ffn_w_gate, ffn_w_up, ffn_w_down):
    b, l, _ = h.shape
    hn = _rmsnorm(h, g_mix_pre) * valid[None, :, None].astype(h.dtype)
    u = (hn @ w_in).astype(F32)
    split_points = [int(p) for p in np.cumsum(IN_SPLIT_SIZES)[:-1]]
    (sb_q, sb_k, sb_v, gla_q, gla_k, gla_v, gla_r, gla_code,
     ml_qk, ml_v, ml_i, ml_f, ml_o, ret_q, ret_k, ret_v, ret_g, merge_logits) = jnp.split(u, split_points, axis=-1)
    y_sb = _stick_breaking(sb_q, sb_k, sb_v, valid)
    y_gla = _gla(gla_q, gla_k, gla_v, gla_r, gla_code, gla_w_gate_up, gla_b_gate, gla_norm)
    y_ml = _mlstm(ml_qk, ml_v, ml_i, ml_f, ml_o, ml_conv, ml_b_i, ml_b_f, ml_norm)
    y_ret = _retention(ret_q, ret_k, ret_v, ret_g, positions, ret_norm)
    gates = jax.nn.sigmoid(merge_logits.reshape(b, l, N_BRANCH, D_MODEL) + b_merge.astype(F32))
    branches = (y_sb, y_gla, y_ml, y_ret)
    merged = gates[:, :, 0] * (branches[0] @ w_branch[0].astype(F32))
    for n in range(1, N_BRANCH):
        merged = merged + gates[:, :, n] * (branches[n] @ w_branch[n].astype(F32))
    mix_out = (merged @ w_out.astype(F32)).astype(h.dtype)
    h = h + _rmsnorm(mix_out, g_mix_post)
    f = _rmsnorm(h, g_ffn_pre)
    ffn_out = (jax.nn.silu(f @ ffn_w_gate) * (f @ ffn_w_up)) @ ffn_w_down
    return h + _rmsnorm(ffn_out.astype(h.dtype), g_ffn_post)


def setup_inputs(seed: int = 0) -> dict:
    key = jax.random.key(seed)
    ks = jax.random.split(key, 24)

    def nrm(k, shape, scale):
        return jax.random.normal(k, shape, F32) * scale

    def gain(k, shape):
        return 1.0 + 0.02 * jax.random.normal(k, shape, F32)

    return {
        'x': nrm(ks[0], (BATCH, SEQ, D_MODEL), 1.0),
        'meta_tokens': nrm(ks[1], (N_META, D_MODEL), 1.0),
        'norm_mix_pre': gain(ks[2], (DEPTH, D_MODEL)),
        'norm_mix_post': gain(ks[3], (DEPTH, D_MODEL)),
        'norm_ffn_pre': gain(ks[4], (DEPTH, D_MODEL)),
        'norm_ffn_post': gain(ks[5], (DEPTH, D_MODEL)),
        'w_in': nrm(ks[6], (DEPTH, D_MODEL, IN_WIDTH), D_MODEL ** -0.5),
        'gla_w_gate_up': nrm(ks[7], (DEPTH, GLA_LOW_RANK, GLA_HEADS * GLA_DK), GLA_LOW_RANK ** -0.5),
        'gla_b_gate': nrm(ks[8], (DEPTH, GLA_HEADS * GLA_DK), 0.1),
        'gla_norm': gain(ks[9], (DEPTH, GLA_HEADS * GLA_DV)),
        'ml_conv': nrm(ks[10], (DEPTH, CONV_WIDTH, 2 * BRANCH_WIDTH), CONV_WIDTH ** -0.5),
        'ml_b_i': nrm(ks[11], (DEPTH, ML_HEADS), 0.1),
        'ml_b_f': jnp.linspace(3.0, 6.0, ML_HEADS, dtype=F32)[None, :] + nrm(ks[12], (DEPTH, ML_HEADS), 0.1),
        'ml_norm': gain(ks[13], (DEPTH, BRANCH_WIDTH)),
        'ret_norm': gain(ks[14], (DEPTH, BRANCH_WIDTH)),
        'w_branch': nrm(ks[15], (DEPTH, N_BRANCH, BRANCH_WIDTH, D_MODEL), BRANCH_WIDTH ** -0.5),
        'b_merge': nrm(ks[16], (DEPTH, N_BRANCH, D_MODEL), 0.1),
        'w_out': nrm(ks[17], (DEPTH, D_MODEL, D_MODEL), D_MODEL ** -0.5),
        'ffn_w_gate': nrm(ks[18], (DEPTH, D_MODEL, D_FF), D_MODEL ** -0.5),
        'ffn_w_up': nrm(ks[19], (DEPTH, D_MODEL, D_FF), D_MODEL ** -0.5),
        'ffn_w_down': nrm(ks[20], (DEPTH, D_FF, D_MODEL), D_FF ** -0.5),
    }


def reference(x, meta_tokens, norm_mix_pre, norm_mix_post, norm_ffn_pre, norm_ffn_post, w_in,
              gla_w_gate_up, gla_b_gate, gla_norm, ml_conv, ml_b_i, ml_b_f, ml_norm, ret_norm,
              w_branch, b_merge, w_out, ffn_w_gate, ffn_w_up, ffn_w_down):
    b = x.shape[0]
    pad = jnp.zeros((b, N_FRONT_PAD, D_MODEL), x.dtype)
    meta = jnp.broadcast_to(meta_tokens.astype(x.dtype)[None], (b, N_META, D_MODEL))
    h = jnp.concatenate([pad, meta, x], axis=1)
    positions = jnp.arange(h.shape[1], dtype=jnp.int32) - N_FRONT_PAD
    valid = positions >= 0
    for layer in range(DEPTH):
        h = _hybrid_layer(h, valid, positions,
                          norm_mix_pre[layer], norm_mix_post[layer], norm_ffn_pre[layer], norm_ffn_post[layer],
                          w_in[layer], gla_w_gate_up[layer], gla_b_gate[layer], gla_norm[layer],
                          ml_conv[layer], ml_b_i[layer], ml_b_f[layer], ml_norm[layer], ret_norm[layer],
                          w_branch[layer], b_merge[layer], w_out[layer],
                          ffn_w_gate[layer], ffn_w_up[layer], ffn_w_down[layer])
    return h[:, BLOCK:, :]
```

```cpp
#include <hip/hip_runtime.h>
#include <hip/hip_cooperative_groups.h>
#include <cstdio>
#include <cstdint>
namespace cg = cooperative_groups;

typedef unsigned short bf16;
typedef __attribute__((ext_vector_type(8))) short bf16x8;
typedef __attribute__((ext_vector_type(4))) short bf16x4;
typedef __attribute__((ext_vector_type(4))) float f32x4;

constexpr int NT = 512;
constexpr int D = 1024, NB = 2, SEQ = 8192, LT = 8320, MROWS = NB * LT, DEPTH = 4, NCH = 65, US = 7704, FF = 2816;
constexpr int NPAD_IN = 7936;
constexpr int C_SBQ = 0, C_SBK = 256, C_SBV = 512, C_GQ = 768, C_GK = 896, C_GV = 1024, C_GR = 1280, C_GC = 1536,
              C_MQK = 1552, C_MV = 2064, C_MI = 2320, C_MF = 2324, C_MO = 2328, C_RQ = 2584, C_RK = 2840, C_RV = 3096,
              C_RG = 3352, C_MG = 3608;
constexpr int RB = 8208, RREAL = 2 * RB, PADB = 112;
constexpr int LROW0 = 64 * 256;
constexpr int NUNIT = NB * 4 * NCH;
constexpr int SB_M1 = 488;
constexpr int LDS_MAIN = 136192;
constexpr int LDS_BYTES = LDS_MAIN + 64;
constexpr float EPS = 1e-6f;

constexpr size_t al256(size_t x) { return (x + 255) & ~(size_t)255; }
constexpr size_t OFF_h = 0;
constexpr size_t OFF_xn = OFF_h + al256((size_t)MROWS * D * 4);
constexpr size_t OFF_U = OFF_xn + al256((size_t)MROWS * D * 2);
constexpr size_t OFF_y = OFF_U + al256((size_t)MROWS * US * 2);
constexpr size_t OFF_mlqk = OFF_y + al256((size_t)MROWS * D * 2);
constexpr size_t OFF_Win_t = OFF_mlqk + al256((size_t)MROWS * 512 * 2);
constexpr size_t OFF_Wb_t = OFF_Win_t + al256((size_t)NPAD_IN * D * 2);
constexpr size_t OFF_Wo_t = OFF_Wb_t + al256((size_t)4 * 1024 * 256 * 2);
constexpr size_t OFF_Wgu_t = OFF_Wo_t + al256((size_t)1024 * 1024 * 2);
constexpr size_t OFF_Wd_t = OFF_Wgu_t + al256((size_t)2 * FF * D * 2);
constexpr size_t OFF_gla_loc = OFF_Wd_t + al256((size_t)D * FF * 2);
constexpr size_t OFF_gla_dec = OFF_gla_loc + al256((size_t)NUNIT * 2048 * 4);
constexpr size_t OFF_ml_c = OFF_gla_dec + al256((size_t)NUNIT * 32 * 4);
constexpr size_t OFF_ml_n = OFF_ml_c + al256((size_t)NUNIT * 4096 * 4);
constexpr size_t OFF_ml_fl = OFF_ml_n + al256((size_t)NUNIT * 64 * 4);
constexpr size_t OFF_ml_al = OFF_ml_fl + al256((size_t)NUNIT * 4);
constexpr size_t OFF_ml_mprev = OFF_ml_al + al256((size_t)NUNIT * 4);
constexpr size_t OFF_ml_g = OFF_ml_mprev + al256((size_t)NUNIT * 4);
constexpr size_t OFF_ml_pm = OFF_ml_g + al256((size_t)MROWS * 4 * 4);
constexpr size_t OFF_ml_cf = OFF_ml_pm + al256((size_t)MROWS * 4 * 4);
constexpr size_t OFF_ret_loc = OFF_ml_cf + al256((size_t)MROWS * 4 * 4);
constexpr size_t OFF_rope_cos = OFF_ret_loc + al256((size_t)NUNIT * 4096 * 4);
constexpr size_t OFF_rope_sin = OFF_rope_cos + al256((size_t)LT * 32 * 4);
constexpr size_t OFF_tmp = OFF_rope_sin + al256((size_t)LT * 32 * 4);
constexpr size_t OFF_bar = OFF_tmp + al256((size_t)32 * D * 4);
constexpr size_t OFF_ex1 = OFF_bar + al256((size_t)(3456 + 1024) * 4);
constexpr size_t OFF_ex2 = OFF_ex1 + al256((size_t)64 * 4 * 256 * 4);
constexpr size_t WS_TOTAL = OFF_ex2 + al256((size_t)64 * 4 * 256 * 4);
struct P {
  const float *x, *meta, *g_mix_pre, *g_mix_post, *g_ffn_pre, *g_ffn_post, *w_in, *gla_wg, *gla_bg, *gla_norm, *ml_conv,
      *ml_bi, *ml_bf, *ml_norm, *ret_norm, *w_branch, *b_merge, *w_out, *w_gate, *w_up, *w_down;
  float* out;
  char* ws;
  __device__ __forceinline__ bf16* h() const { unsigned o_ = (unsigned)(OFF_h); asm volatile("" : "+s"(o_)); return (bf16*)(ws + o_); }
  __device__ __forceinline__ bf16* xn() const { unsigned o_ = (unsigned)(OFF_xn); asm volatile("" : "+s"(o_)); return (bf16*)(ws + o_); }
  __device__ __forceinline__ bf16* U() const { unsigned o_ = (unsigned)(OFF_U); asm volatile("" : "+s"(o_)); return (bf16*)(ws + o_); }
  __device__ __forceinline__ bf16* y() const { unsigned o_ = (unsigned)(OFF_y); asm volatile("" : "+s"(o_)); return (bf16*)(ws + o_); }
  __device__ __forceinline__ bf16* mlqk() const { unsigned o_ = (unsigned)(OFF_mlqk); asm volatile("" : "+s"(o_)); return (bf16*)(ws + o_); }
  __device__ __forceinline__ bf16* Win_t() const { unsigned o_ = (unsigned)(OFF_Win_t); asm volatile("" : "+s"(o_)); return (bf16*)(ws + o_); }
  __device__ __forceinline__ bf16* Wb_t() const { unsigned o_ = (unsigned)(OFF_Wb_t); asm volatile("" : "+s"(o_)); return (bf16*)(ws + o_); }
  __device__ __forceinline__ bf16* Wo_t() const { unsigned o_ = (unsigned)(OFF_Wo_t); asm volatile("" : "+s"(o_)); return (bf16*)(ws + o_); }
  __device__ __forceinline__ bf16* Wgu_t() const { unsigned o_ = (unsigned)(OFF_Wgu_t); asm volatile("" : "+s"(o_)); return (bf16*)(ws + o_); }
  __device__ __forceinline__ bf16* Wd_t() const { unsigned o_ = (unsigned)(OFF_Wd_t); asm volatile("" : "+s"(o_)); return (bf16*)(ws + o_); }
  __device__ __forceinline__ float* gla_loc() const { unsigned o_ = (unsigned)(OFF_gla_loc); asm volatile("" : "+s"(o_)); return (float*)(ws + o_); }
  __device__ __forceinline__ float* gla_dec() const { unsigned o_ = (unsigned)(OFF_gla_dec); asm volatile("" : "+s"(o_)); return (float*)(ws + o_); }
  __device__ __forceinline__ float* ml_c() const { unsigned o_ = (unsigned)(OFF_ml_c); asm volatile("" : "+s"(o_)); return (float*)(ws + o_); }
  __device__ __forceinline__ float* ml_n() const { unsigned o_ = (unsigned)(OFF_ml_n); asm volatile("" : "+s"(o_)); return (float*)(ws + o_); }
  __device__ __forceinline__ float* ml_fl() const { unsigned o_ = (unsigned)(OFF_ml_fl); asm volatile("" : "+s"(o_)); return (float*)(ws + o_); }
  __device__ __forceinline__ float* ml_al() const { unsigned o_ = (unsigned)(OFF_ml_al); asm volatile("" : "+s"(o_)); return (float*)(ws + o_); }
  __device__ __forceinline__ float* ml_mprev() const { unsigned o_ = (unsigned)(OFF_ml_mprev); asm volatile("" : "+s"(o_)); return (float*)(ws + o_); }
  __device__ __forceinline__ float* ml_g() const { unsigned o_ = (unsigned)(OFF_ml_g); asm volatile("" : "+s"(o_)); return (float*)(ws + o_); }
  __device__ __forceinline__ float* ml_pm() const { unsigned o_ = (unsigned)(OFF_ml_pm); asm volatile("" : "+s"(o_)); return (float*)(ws + o_); }
  __device__ __forceinline__ float* ml_cf() const { unsigned o_ = (unsigned)(OFF_ml_cf); asm volatile("" : "+s"(o_)); return (float*)(ws + o_); }
  __device__ __forceinline__ float* ret_loc() const { unsigned o_ = (unsigned)(OFF_ret_loc); asm volatile("" : "+s"(o_)); return (float*)(ws + o_); }
  __device__ __forceinline__ float* rope_cos() const { unsigned o_ = (unsigned)(OFF_rope_cos); asm volatile("" : "+s"(o_)); return (float*)(ws + o_); }
  __device__ __forceinline__ float* rope_sin() const { unsigned o_ = (unsigned)(OFF_rope_sin); asm volatile("" : "+s"(o_)); return (float*)(ws + o_); }
  __device__ __forceinline__ float* tmp() const { unsigned o_ = (unsigned)(OFF_U + (size_t)100663296); asm volatile("" : "+s"(o_)); return (float*)(ws + o_); }
  __device__ __forceinline__ unsigned* bar() const { unsigned o_ = (unsigned)(OFF_bar); asm volatile("" : "+s"(o_)); return (unsigned*)(ws + o_); }
  __device__ __forceinline__ unsigned* cnt() const { unsigned o_ = (unsigned)(OFF_bar + 3456 * 4); asm volatile("" : "+s"(o_)); return (unsigned*)(ws + o_); }
  __device__ __forceinline__ float* ex1() const { unsigned o_ = (unsigned)(OFF_ex1); asm volatile("" : "+s"(o_)); return (float*)(ws + o_); }
  __device__ __forceinline__ float* ex2() const { unsigned o_ = (unsigned)(OFF_ex2); asm volatile("" : "+s"(o_)); return (float*)(ws + o_); }
  __device__ __forceinline__ bf16* act() const { unsigned o_ = (unsigned)(OFF_U); asm volatile("" : "+s"(o_)); return (bf16*)(ws + o_); }
};

__device__ __forceinline__ size_t rowof(int b, int s) { return (size_t)((s >= PADB) ? b * RB + s - PADB : RREAL + b * PADB + s); }
#define TROW(t) ((size_t)((c == 0 && (t) < PADB) ? rpad + (t) : rbase + (t)))
__device__ __forceinline__ float bf2f(bf16 h) { return __uint_as_float(((unsigned)h) << 16); }
__device__ __forceinline__ unsigned pk2(float a, float b) { unsigned r; asm("v_cvt_pk_bf16_f32 %0, %1, %2" : "=v"(r) : "v"(a), "v"(b)); return r; }
__device__ __forceinline__ bf16 f2bf(float f) { return (bf16)(pk2(f, 0.f) & 0xffffu); }
__device__ __forceinline__ float lo16(unsigned v) { return __uint_as_float(v << 16); }
__device__ __forceinline__ float hi16(unsigned v) { return __uint_as_float(v & 0xffff0000u); }
__device__ __forceinline__ float sigm(float x) { return __builtin_amdgcn_rcpf(1.f + __expf(-x)); }
__device__ __forceinline__ float silu(float x) { return x * sigm(x); }
__device__ __forceinline__ float logsig(float x) { return fminf(x, 0.f) - __logf(1.f + __expf(-fabsf(x))); }
__device__ __forceinline__ float softplus(float x) { return fmaxf(x, 0.f) + __logf(1.f + __expf(-fabsf(x))); }
__device__ __forceinline__ float wave_sum(float v) {
#pragma unroll
  for (int o = 1; o < 64; o <<= 1) v += __shfl_xor(v, o);
  return v;
}
__device__ __forceinline__ float scan_add(float v, int lane) {
#pragma unroll
  for (int o = 1; o < 64; o <<= 1) { float t = __shfl_up(v, o); if (lane >= o) v += t; }
  return v;
}
__device__ __forceinline__ float scan_max(float v, int lane) {
#pragma unroll
  for (int o = 1; o < 64; o <<= 1) { float t = __shfl_up(v, o); if (lane >= o) v = fmaxf(v, t); }
  return v;
}
__device__ __forceinline__ int obid() { int b = blockIdx.x; asm volatile("" : "+s"(b)); return b; }
__device__ __forceinline__ int otid() { int t = threadIdx.x; asm volatile("" : "+v"(t)); return t; }
#define MFMA(a, b, c) __builtin_amdgcn_mfma_f32_16x16x32_bf16((a), (b), (c), 0, 0, 0)

#define UNPK8(v, f) { f[0] = lo16(v.x); f[1] = hi16(v.x); f[2] = lo16(v.y); f[3] = hi16(v.y); f[4] = lo16(v.z); f[5] = hi16(v.z); f[6] = lo16(v.w); f[7] = hi16(v.w); }

__device__ __forceinline__ void write_xn_row(bf16* dst, const float4 (&v)[4], float rs, const float* g, int lane, bool valid) {
#pragma unroll
  for (int i = 0; i < 4; ++i) {
    const int c = i * 256 + lane * 4;
    float4 gg = *(const float4*)(g + c);
    uint2 o;
    if (valid) { o.x = pk2(v[i].x * rs * gg.x, v[i].y * rs * gg.y); o.y = pk2(v[i].z * rs * gg.z, v[i].w * rs * gg.w); }
    else { o.x = 0u; o.y = 0u; }
    *(uint2*)(dst + c) = o;
  }
}

__device__ void phase_init_rows(const P& p) {
  const int tid_ = otid();
  const int lane = tid_ & 63;
  const int gw = blockIdx.x * (NT / 64) + (tid_ >> 6), nw = gridDim.x * (NT / 64);
  for (int row = gw; row < MROWS; row += nw) {
    const float* src = nullptr;
    if (row < RREAL) {
      const int b = row / RB, tt = row % RB + PADB;
      src = (tt >= 128) ? (p.x + ((size_t)b * SEQ + (tt - 128)) * D) : (p.meta + (size_t)(tt - PADB) * D);
    }
    float4 v[4];
    float ss = 0.f;
#pragma unroll
    for (int i = 0; i < 4; ++i) {
      if (src) v[i] = *(const float4*)(src + i * 256 + lane * 4); else v[i] = make_float4(0.f, 0.f, 0.f, 0.f);
      ss += v[i].x * v[i].x + v[i].y * v[i].y + v[i].z * v[i].z + v[i].w * v[i].w;
      { uint2 hb_; hb_.x = pk2(v[i].x, v[i].y); hb_.y = pk2(v[i].z, v[i].w); *(uint2*)(p.h() + (size_t)row * D + i * 256 + lane * 4) = hb_; }
    }
    ss = wave_sum(ss);
    const float rs = rsqrtf(ss * (1.f / D) + EPS);
    write_xn_row(p.xn() + (size_t)row * D, v, rs, p.g_mix_pre, lane, row < RREAL);
  }
}

__device__ void phase_norm(const P& p, const float* gpost, const float* gnext, bool last, int rowbeg, int rowend) {
  const int tid_ = otid();
  const int lane = tid_ & 63;
  const int gw = blockIdx.x * (NT / 64) + (tid_ >> 6), nw = gridDim.x * (NT / 64);
  for (int row = rowbeg + gw; row < rowend; row += nw) {
    const int b = row / RB, t = row % RB + PADB;
    float4 m[4], hv[4];
    float ss = 0.f;
#pragma unroll
    for (int i = 0; i < 4; ++i) {
      m[i] = *(const float4*)(p.tmp() + (size_t)row * D + i * 256 + lane * 4);
      { const uint2 hb_ = *(const uint2*)(p.h() + (size_t)row * D + i * 256 + lane * 4); hv[i] = make_float4(lo16(hb_.x), hi16(hb_.x), lo16(hb_.y), hi16(hb_.y)); }
      ss += m[i].x * m[i].x + m[i].y * m[i].y + m[i].z * m[i].z + m[i].w * m[i].w;
    }
    ss = wave_sum(ss);
    const float rs = rsqrtf(ss * (1.f / D) + EPS);
    float ss2 = 0.f;
#pragma unroll
    for (int i = 0; i < 4; ++i) {
      float4 gg = *(const float4*)(gpost + i * 256 + lane * 4);
      hv[i].x += m[i].x * rs * gg.x; hv[i].y += m[i].y * rs * gg.y; hv[i].z += m[i].z * rs * gg.z; hv[i].w += m[i].w * rs * gg.w;
      ss2 += hv[i].x * hv[i].x + hv[i].y * hv[i].y + hv[i].z * hv[i].z + hv[i].w * hv[i].w;
    }
    if (last) {
      if (t >= 128) {
#pragma unroll
        for (int i = 0; i < 4; ++i) *(float4*)(p.out + ((size_t)b * SEQ + (t - 128)) * D + i * 256 + lane * 4) = hv[i];
      }
    } else {
#pragma unroll
      for (int i = 0; i < 4; ++i) { uint2 hb_; hb_.x = pk2(hv[i].x, hv[i].y); hb_.y = pk2(hv[i].z, hv[i].w); *(uint2*)(p.h() + (size_t)row * D + i * 256 + lane * 4) = hb_; }
      ss2 = wave_sum(ss2);
      const float rs2 = rsqrtf(ss2 * (1.f / D) + EPS);
      write_xn_row(p.xn() + (size_t)row * D, hv, rs2, gnext, lane, true);
    }
  }
}

__device__ void phase_rope(const P& p) {
  const int g = blockIdx.x * NT + otid(), n = gridDim.x * NT;
  for (int idx = g; idx < LT * 32; idx += n) {
    const int s = idx >> 5, i = idx & 31;
    const double invf = exp2(-(double)i * (13.287712379549449 / 32.0));
    const float invf32 = (float)invf;
    const float angf = (float)(s - 112) * invf32;
    double rev = (double)angf * 0.15915494309189535;
    rev -= floor(rev);
    const float rf = (float)rev;
    p.rope_cos()[idx] = __builtin_amdgcn_cosf(rf);
    p.rope_sin()[idx] = __builtin_amdgcn_sinf(rf);
  }
}

__device__ __forceinline__ void cvt_item(const float* W, int K, int N, bf16* Wt, int Npad, int mode, int item, float* scr, int lane) {
  const int nblk = Npad / 32, kb = item / nblk, nb = item % nblk, k0 = 64 * kb, n0 = 32 * nb;
  const int nn = n0 + (lane & 31);
  const bool ok = nn < N;
  {
    const float* wp = W + (size_t)(k0 + (lane >> 5)) * N + (ok ? nn : 0);
    const size_t step = (size_t)2 * N;
    float v[32];
#pragma unroll
    for (int i = 0; i < 32; ++i) { v[i] = *wp; wp += step; }
#pragma unroll
    for (int i = 0; i < 32; ++i) scr[(2 * i + (lane >> 5)) * 33 + (lane & 31)] = ok ? v[i] : 0.f;
  }
  asm volatile("s_waitcnt lgkmcnt(0)" ::: "memory");
  const int c = lane & 7;
#pragma unroll
  for (int j = 0; j < 4; ++j) {
    const int n = (lane >> 3) + 8 * j;
    const float* sp = scr + (8 * c) * 33 + n;
    uint4 o;
    o.x = pk2(sp[0 * 33], sp[1 * 33]); o.y = pk2(sp[2 * 33], sp[3 * 33]); o.z = pk2(sp[4 * 33], sp[5 * 33]); o.w = pk2(sp[6 * 33], sp[7 * 33]);
    const int rn = n0 + n;
    int dst = rn;
    if (mode == 1) dst = (rn >> 7) * 256 + (rn & 127);
    if (mode == 2) dst = (rn >> 7) * 256 + 128 + (rn & 127);
    *(uint4*)(Wt + (size_t)dst * K + k0 + 8 * c) = o;
  }
  asm volatile("s_waitcnt lgkmcnt(0)" ::: "memory");
}

constexpr int CU_IN = 16 * (NPAD_IN / 32);
constexpr int CU_WB = 4 * 4 * 32;
constexpr int CU_WO = 16 * 32;
constexpr int CU_WG = 16 * 88;
constexpr int CU_WD = 44 * 32;
constexpr int CU_LATE = CU_WB + CU_WO + 2 * CU_WG + CU_WD;

__device__ void cvt_late(const P& p, int layer, int u, float* scr, int lane) {
  if (u < CU_WB) { const int br = u / 128, uu = u % 128;
    cvt_item(p.w_branch + ((size_t)layer * 4 + br) * 256 * 1024, 256, 1024, p.Wb_t() + (size_t)br * 1024 * 256, 1024, 0, uu, scr, lane); return; }
  u -= CU_WB;
  if (u < CU_WO) { cvt_item(p.w_out + (size_t)layer * 1024 * 1024, 1024, 1024, p.Wo_t(), 1024, 0, u, scr, lane); return; }
  u -= CU_WO;
  if (u < CU_WG) { cvt_item(p.w_gate + (size_t)layer * 1024 * FF, 1024, FF, p.Wgu_t(), FF, 1, u, scr, lane); return; }
  u -= CU_WG;
  if (u < CU_WG) { cvt_item(p.w_up + (size_t)layer * 1024 * FF, 1024, FF, p.Wgu_t(), FF, 2, u, scr, lane); return; }
  u -= CU_WG;
  cvt_item(p.w_down + (size_t)layer * FF * 1024, FF, 1024, p.Wd_t(), 1024, 0, u, scr, lane);
}
__device__ void cvt_in(const P& p, int layer, int u, float* scr, int lane) {
  cvt_item(p.w_in + (size_t)layer * 1024 * US, 1024, US, p.Win_t(), NPAD_IN, 0, u, scr, lane);
}
__device__ void phase_cvt(const P& p, int late_layer, int in_layer, char* smem) {
  const int tid = otid(), lane = tid & 63, w = tid >> 6;
  float* scr = (float*)smem + w * (64 * 33);
  const int gw = blockIdx.x * (NT / 64) + w, nw = gridDim.x * (NT / 64);
  __syncthreads();
  if (late_layer >= 0) for (int u = gw; u < CU_LATE; u += nw) cvt_late(p, late_layer, u, scr, lane);
  if (in_layer >= 0) for (int u = gw; u < CU_IN; u += nw) cvt_in(p, in_layer, u, scr, lane);
  __syncthreads();
}

__device__ __forceinline__ void gemm_mainloop(const bf16* __restrict__ A, int lda, const bf16* __restrict__ Bt, int ldb, int K,
                                              int row0, int col0, f32x4 (&acc)[4][4], bf16* lds) {
  const int tid = otid(), lane = tid & 63, w = tid >> 6, wm = w >> 1, wn = w & 1, r = lane & 15, q = lane >> 4;
  bf16* As = lds;
  bf16* Bs = lds + 2 * 256 * 72;
  const int lr = tid >> 3, lc = (tid & 7) * 8;
  const bf16* ga = A + (size_t)(row0 + lr) * lda + lc;
  const bf16* gb = Bt + (size_t)(col0 + lr) * ldb + lc;
  uint4 ra[4], rb[2];
  const int nk = K / 64;
#pragma unroll
  for (int i = 0; i < 4; ++i) ra[i] = *(const uint4*)(ga + (size_t)(64 * i) * lda);
#pragma unroll
  for (int i = 0; i < 2; ++i) rb[i] = *(const uint4*)(gb + (size_t)(64 * i) * ldb);
#pragma unroll
  for (int i = 0; i < 4; ++i) *(uint4*)(As + (lr + 64 * i) * 72 + lc) = ra[i];
#pragma unroll
  for (int i = 0; i < 2; ++i) *(uint4*)(Bs + (lr + 64 * i) * 72 + lc) = rb[i];
  __syncthreads();
  for (int kt = 0; kt < nk; ++kt) {
    const int cur = kt & 1;
    const bool more = (kt + 1 < nk);
    if (more) {
#pragma unroll
      for (int i = 0; i < 4; ++i) ra[i] = *(const uint4*)(ga + (size_t)(64 * i) * lda + (kt + 1) * 64);
#pragma unroll
      for (int i = 0; i < 2; ++i) rb[i] = *(const uint4*)(gb + (size_t)(64 * i) * ldb + (kt + 1) * 64);
    }
    const bf16* as = As + cur * 256 * 72 + (wm * 64 + r) * 72 + q * 8;
    const bf16* bs = Bs + cur * 128 * 72 + (wn * 64 + r) * 72 + q * 8;
#pragma unroll
    for (int ks = 0; ks < 2; ++ks) {
      bf16x8 af[4], bfr[4];
#pragma unroll
      for (int mt = 0; mt < 4; ++mt) af[mt] = *(const bf16x8*)(as + mt * 16 * 72 + ks * 32);
#pragma unroll
      for (int nt = 0; nt < 4; ++nt) bfr[nt] = *(const bf16x8*)(bs + nt * 16 * 72 + ks * 32);
#pragma unroll
      for (int nt = 0; nt < 4; ++nt)
#pragma unroll
        for (int mt = 0; mt < 4; ++mt) acc[nt][mt] = MFMA(bfr[nt], af[mt], acc[nt][mt]);
    }
    if (more) {
      const int nx = cur ^ 1;
#pragma unroll
      for (int i = 0; i < 4; ++i) *(uint4*)(As + nx * 256 * 72 + (lr + 64 * i) * 72 + lc) = ra[i];
#pragma unroll
      for (int i = 0; i < 2; ++i) *(uint4*)(Bs + nx * 128 * 72 + (lr + 64 * i) * 72 + lc) = rb[i];
    }
    __syncthreads();
  }
}

__device__ __forceinline__ void tile_coords(int id, int ntn, int& tm, int& tn, int NTM = MROWS / 256) {
  constexpr int GM = 16;
  const int per = GM * ntn;
  const int g = id / per, rem = id % per;
  const int gsz = (NTM - g * GM) < GM ? (NTM - g * GM) : GM;
  tm = g * GM + rem % gsz;
  tn = rem / gsz;
}

#define ZERO_ACC(acc) { _Pragma("unroll") for (int a_ = 0; a_ < 4; ++a_) _Pragma("unroll") for (int b_ = 0; b_ < 4; ++b_) acc[a_][b_] = f32x4{0.f, 0.f, 0.f, 0.f}; }

__device__ void phase_gemm_u(const P& p, bf16* lds) {
  constexpr int NTN = NPAD_IN / 128;
  const int tid_ = otid();
  const int lane = tid_ & 63, w = tid_ >> 6, wm = w >> 1, wn = w & 1, r = lane & 15, q = lane >> 4;
  for (int id = blockIdx.x; id < 65 * NTN; id += gridDim.x) {
    int tm, tn; tile_coords(id, NTN, tm, tn);
    const int row0 = tm * 256, col0 = tn * 128;
    f32x4 acc[4][4]; ZERO_ACC(acc);
    gemm_mainloop(p.xn(), D, p.Win_t(), D, D, row0, col0, acc, lds);
#pragma unroll
    for (int nt = 0; nt < 4; ++nt) {
      const int n = col0 + wn * 64 + nt * 16 + 4 * q;
      if (n < US) {
#pragma unroll
        for (int mt = 0; mt < 4; ++mt) {
          const int m = row0 + wm * 64 + mt * 16 + r;
          uint2 o; o.x = pk2(acc[nt][mt][0], acc[nt][mt][1]); o.y = pk2(acc[nt][mt][2], acc[nt][mt][3]);
          *(uint2*)(p.U() + (size_t)m * US + n) = o;
        }
      }
    }
  }
}

__device__ void phase_gemm_merge(const P& p, int layer, bf16* lds) {
  constexpr int NTN = 8, NTM = LROW0 / 128, LDT = 264;
  const int tid = otid();
  const int lane = tid & 63, w = tid >> 6, wm = w >> 1, wn = w & 1, r = lane & 15, q = lane >> 4;
  bf16* As = lds;
  bf16* Bs = lds + 128 * LDT;
  const int lrow = tid >> 5, lcol = (tid & 31) * 8;
  const int pbase = 16 * ((lrow >> 2) & 1) + 4 * (lrow >> 3) + (lrow & 3);
  const int ntile = (NTM * NTN - (int)blockIdx.x + (int)gridDim.x - 1) / (int)gridDim.x;
  const int nit = ntile * 4;
  if (nit <= 0) return;
  uint4 ra0, ra1, ra2, ra3, ra4, ra5, ra6, ra7, rb0, rb1, rb2, rb3, rb4, rb5, rb6, rb7;
  {
    int tm, tn; tile_coords(blockIdx.x, NTN, tm, tn, NTM);
    const bf16* ga = p.y() + (size_t)(tm * 128 + lrow) * D + lcol;
    const bf16* gb = p.Wb_t() + (size_t)(tn * 128 + lrow) * 256 + lcol;
    ra0 = *(const uint4*)(ga + (size_t)(16 * 0) * D); ra1 = *(const uint4*)(ga + (size_t)(16 * 1) * D); ra2 = *(const uint4*)(ga + (size_t)(16 * 2) * D); ra3 = *(const uint4*)(ga + (size_t)(16 * 3) * D); ra4 = *(const uint4*)(ga + (size_t)(16 * 4) * D); ra5 = *(const uint4*)(ga + (size_t)(16 * 5) * D); ra6 = *(const uint4*)(ga + (size_t)(16 * 6) * D); ra7 = *(const uint4*)(ga + (size_t)(16 * 7) * D);
    rb0 = *(const uint4*)(gb + (size_t)(16 * 0) * 256); rb1 = *(const uint4*)(gb + (size_t)(16 * 1) * 256); rb2 = *(const uint4*)(gb + (size_t)(16 * 2) * 256); rb3 = *(const uint4*)(gb + (size_t)(16 * 3) * 256); rb4 = *(const uint4*)(gb + (size_t)(16 * 4) * 256); rb5 = *(const uint4*)(gb + (size_t)(16 * 5) * 256); rb6 = *(const uint4*)(gb + (size_t)(16 * 6) * 256); rb7 = *(const uint4*)(gb + (size_t)(16 * 7) * 256);
  }
  __syncthreads();
  *(uint4*)(As + (lrow + 16 * 0) * LDT + lcol) = ra0; *(uint4*)(As + (lrow + 16 * 1) * LDT + lcol) = ra1; *(uint4*)(As + (lrow + 16 * 2) * LDT + lcol) = ra2; *(uint4*)(As + (lrow + 16 * 3) * LDT + lcol) = ra3; *(uint4*)(As + (lrow + 16 * 4) * LDT + lcol) = ra4; *(uint4*)(As + (lrow + 16 * 5) * LDT + lcol) = ra5; *(uint4*)(As + (lrow + 16 * 6) * LDT + lcol) = ra6; *(uint4*)(As + (lrow + 16 * 7) * LDT + lcol) = ra7;
  *(uint4*)(Bs + (pbase + 0) * LDT + lcol) = rb0; *(uint4*)(Bs + (pbase + 8) * LDT + lcol) = rb1; *(uint4*)(Bs + (pbase + 32) * LDT + lcol) = rb2; *(uint4*)(Bs + (pbase + 40) * LDT + lcol) = rb3; *(uint4*)(Bs + (pbase + 64) * LDT + lcol) = rb4; *(uint4*)(Bs + (pbase + 72) * LDT + lcol) = rb5; *(uint4*)(Bs + (pbase + 96) * LDT + lcol) = rb6; *(uint4*)(Bs + (pbase + 104) * LDT + lcol) = rb7;
  __syncthreads();
  f32x4 macc[4][2], acc[4][2];
  for (int it = 0; it < nit; ++it) {
    const int br = it & 3;
    int tm, tn; tile_coords(blockIdx.x + (it >> 2) * gridDim.x, NTN, tm, tn, NTM);
    const int row0 = tm * 128, col0 = tn * 128;
#pragma unroll
    for (int a_ = 0; a_ < 4; ++a_)
#pragma unroll
      for (int b_ = 0; b_ < 2; ++b_) { acc[a_][b_] = f32x4{0.f, 0.f, 0.f, 0.f}; if (br == 0) macc[a_][b_] = f32x4{0.f, 0.f, 0.f, 0.f}; }
    const bf16* gU = p.U() + (size_t)(row0 + wm * 32 + r) * US + C_MG + br * 1024 + col0 + wn * 64 + 8 * q;
    uint4 greg[2][2];
#pragma unroll
    for (int pr = 0; pr < 2; ++pr)
#pragma unroll
      for (int mt = 0; mt < 2; ++mt) greg[pr][mt] = *(const uint4*)(gU + (size_t)(mt * 16) * US + pr * 32);
    const bool more = it + 1 < nit;
    if (more) {
      const int itn = it + 1, brn = itn & 3;
      int tmn, tnn; tile_coords(blockIdx.x + (itn >> 2) * gridDim.x, NTN, tmn, tnn, NTM);
      const bf16* ga = p.y() + (size_t)(tmn * 128 + lrow) * D + brn * 256 + lcol;
      const bf16* gb = p.Wb_t() + (size_t)brn * 1024 * 256 + (size_t)(tnn * 128 + lrow) * 256 + lcol;
      ra0 = *(const uint4*)(ga + (size_t)(16 * 0) * D); ra1 = *(const uint4*)(ga + (size_t)(16 * 1) * D); ra2 = *(const uint4*)(ga + (size_t)(16 * 2) * D); ra3 = *(const uint4*)(ga + (size_t)(16 * 3) * D); ra4 = *(const uint4*)(ga + (size_t)(16 * 4) * D); ra5 = *(const uint4*)(ga + (size_t)(16 * 5) * D); ra6 = *(const uint4*)(ga + (size_t)(16 * 6) * D); ra7 = *(const uint4*)(ga + (size_t)(16 * 7) * D);
      rb0 = *(const uint4*)(gb + (size_t)(16 * 0) * 256); rb1 = *(const uint4*)(gb + (size_t)(16 * 1) * 256); rb2 = *(const uint4*)(gb + (size_t)(16 * 2) * 256); rb3 = *(const uint4*)(gb + (size_t)(16 * 3) * 256); rb4 = *(const uint4*)(gb + (size_t)(16 * 4) * 256); rb5 = *(const uint4*)(gb + (size_t)(16 * 5) * 256); rb6 = *(const uint4*)(gb + (size_t)(16 * 6) * 256); rb7 = *(const uint4*)(gb + (size_t)(16 * 7) * 256);
    }
    const bf16* as = As + (wm * 32 + r) * LDT + q * 8;
    const bf16* bs = Bs + (wn * 64 + r) * LDT + q * 8;
    {
      bf16x8 af[2][2], bfr[2][4];
#pragma unroll
      for (int mt = 0; mt < 2; ++mt) af[0][mt] = *(const bf16x8*)(as + mt * 16 * LDT);
#pragma unroll
      for (int nt = 0; nt < 4; ++nt) bfr[0][nt] = *(const bf16x8*)(bs + nt * 16 * LDT);
#pragma unroll
      for (int ks = 0; ks < 8; ++ks) {
        const int cb = ks & 1, nb = cb ^ 1;
        if (ks < 7) {
#pragma unroll
          for (int mt = 0; mt < 2; ++mt) af[nb][mt] = *(const bf16x8*)(as + mt * 16 * LDT + (ks + 1) * 32);
#pragma unroll
          for (int nt = 0; nt < 4; ++nt) bfr[nb][nt] = *(const bf16x8*)(bs + nt * 16 * LDT + (ks + 1) * 32);
        }
        __builtin_amdgcn_sched_barrier(0);
#pragma unroll
        for (int nt = 0; nt < 4; ++nt)
#pragma unroll
          for (int mt = 0; mt < 2; ++mt) acc[nt][mt] = MFMA(bfr[cb][nt], af[cb][mt], acc[nt][mt]);
        __builtin_amdgcn_sched_barrier(0);
      }
    }
    __syncthreads();
    if (more) {
      *(uint4*)(As + (lrow + 16 * 0) * LDT + lcol) = ra0; *(uint4*)(As + (lrow + 16 * 1) * LDT + lcol) = ra1; *(uint4*)(As + (lrow + 16 * 2) * LDT + lcol) = ra2; *(uint4*)(As + (lrow + 16 * 3) * LDT + lcol) = ra3; *(uint4*)(As + (lrow + 16 * 4) * LDT + lcol) = ra4; *(uint4*)(As + (lrow + 16 * 5) * LDT + lcol) = ra5; *(uint4*)(As + (lrow + 16 * 6) * LDT + lcol) = ra6; *(uint4*)(As + (lrow + 16 * 7) * LDT + lcol) = ra7;
      *(uint4*)(Bs + (pbase + 0) * LDT + lcol) = rb0; *(uint4*)(Bs + (pbase + 8) * LDT + lcol) = rb1; *(uint4*)(Bs + (pbase + 32) * LDT + lcol) = rb2; *(uint4*)(Bs + (pbase + 40) * LDT + lcol) = rb3; *(uint4*)(Bs + (pbase + 64) * LDT + lcol) = rb4; *(uint4*)(Bs + (pbase + 72) * LDT + lcol) = rb5; *(uint4*)(Bs + (pbase + 96) * LDT + lcol) = rb6; *(uint4*)(Bs + (pbase + 104) * LDT + lcol) = rb7;
    }
    __syncthreads();
#pragma unroll
    for (int nt = 0; nt < 4; ++nt) {
      const int n = col0 + wn * 64 + (nt >> 1) * 32 + 8 * q + 4 * (nt & 1);
      const float4 bm = *(const float4*)(p.b_merge + ((size_t)layer * 4 + br) * 1024 + n);
#pragma unroll
      for (int mt = 0; mt < 2; ++mt) {
        const uint4 lg4 = greg[nt >> 1][mt];
        const unsigned gx = (nt & 1) ? lg4.z : lg4.x, gy = (nt & 1) ? lg4.w : lg4.y;
        macc[nt][mt][0] += sigm(lo16(gx) + bm.x) * acc[nt][mt][0];
        macc[nt][mt][1] += sigm(hi16(gx) + bm.y) * acc[nt][mt][1];
        macc[nt][mt][2] += sigm(lo16(gy) + bm.z) * acc[nt][mt][2];
        macc[nt][mt][3] += sigm(hi16(gy) + bm.w) * acc[nt][mt][3];
      }
    }
    if (br == 3) {
#pragma unroll
      for (int pr = 0; pr < 2; ++pr) {
        const int n = col0 + wn * 64 + pr * 32 + 8 * q;
#pragma unroll
        for (int mt = 0; mt < 2; ++mt) {
          const int m = row0 + wm * 32 + mt * 16 + r;
          uint4 o;
          o.x = pk2(macc[2 * pr][mt][0], macc[2 * pr][mt][1]); o.y = pk2(macc[2 * pr][mt][2], macc[2 * pr][mt][3]);
          o.z = pk2(macc[2 * pr + 1][mt][0], macc[2 * pr + 1][mt][1]); o.w = pk2(macc[2 * pr + 1][mt][2], macc[2 * pr + 1][mt][3]);
          *(uint4*)(p.xn() + (size_t)m * D + n) = o;
        }
      }
    }
  }
}

__device__ void phase_gemm_f32(const P& p, const bf16* A, int lda, const bf16* Wt, int K, bf16* lds) {
  constexpr int NTN = 8;
  const int tid_ = otid();
  const int lane = tid_ & 63, w = tid_ >> 6, wm = w >> 1, wn = w & 1, r = lane & 15, q = lane >> 4;
  for (int id = blockIdx.x; id < 65 * NTN; id += gridDim.x) {
    int tm, tn; tile_coords(id, NTN, tm, tn);
    const int row0 = tm * 256, col0 = tn * 128;
    f32x4 acc[4][4]; ZERO_ACC(acc);
    gemm_mainloop(A, lda, Wt, K, K, row0, col0, acc, lds);
#pragma unroll
    for (int nt = 0; nt < 4; ++nt) {
      const int n = col0 + wn * 64 + nt * 16 + 4 * q;
#pragma unroll
      for (int mt = 0; mt < 4; ++mt) {
        const int m = row0 + wm * 64 + mt * 16 + r;
        *(float4*)(p.tmp() + (size_t)m * D + n) = make_float4(acc[nt][mt][0], acc[nt][mt][1], acc[nt][mt][2], acc[nt][mt][3]);
      }
    }
  }
}

__device__ void phase_gemm_gu(const P& p, bf16* lds) {
  constexpr int NTN = 2 * FF / 128;
  const int tid_ = otid();
  const int lane = tid_ & 63, w = tid_ >> 6, wm = w >> 1, wn = w & 1, r = lane & 15, q = lane >> 4;
  for (int id = blockIdx.x; id < 65 * NTN; id += gridDim.x) {
    int tm, tn; tile_coords(id, NTN, tm, tn);
    const int row0 = tm * 256, col0 = tn * 128;
    f32x4 acc[4][4]; ZERO_ACC(acc);
    gemm_mainloop(p.xn(), D, p.Wgu_t(), D, D, row0, col0, acc, lds);
#pragma unroll
    for (int pr = 0; pr < 2; ++pr) {
      const int ac = (col0 + wn * 64 + pr * 32) / 2 + 4 * q;
#pragma unroll
      for (int mt = 0; mt < 4; ++mt) {
        const int m = row0 + wm * 64 + mt * 16 + r;
        float v0 = silu(acc[2 * pr][mt][0]) * acc[2 * pr + 1][mt][0];
        float v1 = silu(acc[2 * pr][mt][1]) * acc[2 * pr + 1][mt][1];
        float v2 = silu(acc[2 * pr][mt][2]) * acc[2 * pr + 1][mt][2];
        float v3 = silu(acc[2 * pr][mt][3]) * acc[2 * pr + 1][mt][3];
        uint2 o; o.x = pk2(v0, v1); o.y = pk2(v2, v3);
        *(uint2*)(p.act() + (size_t)m * FF + ac) = o;
      }
    }
  }
}

namespace pg8 {
#define PG8_LAS __attribute__((address_space(3)))
typedef unsigned short bf16_t;
typedef short bf16x8 __attribute__((ext_vector_type(8)));
typedef float f32x4 __attribute__((ext_vector_type(4)));
typedef unsigned u32x4 __attribute__((ext_vector_type(4)));
constexpr int BM = 256, BK = 64, HALF = 128, HTB = HALF * BK * 2  , STAGE_BYTES = 8 * HTB, NXCD = 8, WGM = 8;

__host__ __device__ __forceinline__ int lds_byte(int r, int c) { const int st = (r >> 4) * 2 + (c >> 5), rr = r & 15, cc = c & 31, ob = rr * 64 + cc * 2; return st * 1024 + (ob ^ (((ob >> 9) & 1) << 5)); }
__host__ __device__ __forceinline__ void stage_rc(int b, int& R, int& C) { const int st = b / 1024, sb = b % 1024, swz = sb ^ (((sb >> 9) & 1) << 5); R = (st >> 1) * 16 + swz / 64; C = (st & 1) * 32 + (swz % 64) / 2; }
__host__ __device__ __forceinline__ int perm32(int rho) { const int n = rho >> 4, i = rho & 15; return 8 * (i >> 2) + 4 * n + (i & 3); }

struct Unit { int pm, pn; };
struct Gemm { const bf16_t* A; const bf16_t* Bt; int M, N, K; };

struct StaticOrder {
    int nM, nN, nwg, G, c;
    __host__ __device__ void init(int M, int N, int G_, int c_) { nM = M / BM; nN = N / BM; nwg = nM * nN; G = G_; c = c_; }
    __host__ __device__ bool next(int i, Unit& u) const {
        const long L = (long)i * G + c; if (L >= nwg) return false;
        int wgid = (int)L; { const int q = nwg / NXCD, r = nwg % NXCD, xcd = wgid % NXCD, off = wgid / NXCD; wgid = (xcd < r ? xcd * (q + 1) : r * (q + 1) + (xcd - r) * q) + off; }
        const int nig = WGM * nN, gid = wgid / nig, fm = gid * WGM, gsz = (nM - fm) < WGM ? (nM - fm) : WGM;
        u.pm = fm + ((wgid % nig) % gsz); u.pn = (wgid % nig) / gsz; return true;
    }
    __device__ __forceinline__ void a_ready(const Unit&) const {}
    __device__ __forceinline__ void done(const Unit&) const {}
};

template <class Epi, class Sched>
__device__ __forceinline__ void gemm_phase(PG8_LAS unsigned char* lds, const Gemm g, const Sched& S, const Epi& E) {
    const int tid = otid(), wid = __builtin_amdgcn_readfirstlane(tid >> 6), lane = tid & 63, wr = wid >> 2, wc = wid & 3, fr = lane & 15, fq = lane >> 4;
    const int K = g.K, nt = K / BK;
    unsigned voffA[2], voffB[2];
#pragma unroll
    for (int i = 0; i < 2; ++i) { int R, C; stage_rc(tid * 16 + i * 8192, R, C); const int Rb = Epi::PERM ? ((R & ~31) + perm32(R & 31)) : R;
        voffA[i] = (unsigned)(R * K + C) * 2u; voffB[i] = (unsigned)(Rb * K + C) * 2u; }
    const size_t kstep = (size_t)(BK * 2);
    const size_t hstep = (size_t)HALF * K * 2;
    const size_t tstep = 2 * hstep;
    const unsigned ldsw = (unsigned)wid * 1024u;
    const int aoff = lds_byte(wr * 64 + fr, fq * 8), boff = lds_byte(wc * 32 + fr, fq * 8);
#define PG8_SA(b, h) (((b) * 2 + (h)) * HTB)
#define PG8_SB(b, h) ((4 + (b) * 2 + (h)) * HTB)
#define PG8_STAGE(bufoff, gbase, voff) do { _Pragma("unroll") for (int _i = 0; _i < 2; ++_i) \
        __builtin_amdgcn_global_load_lds((const unsigned*)((const char*)(gbase) + (voff)[_i]), (PG8_LAS unsigned*)(lds + (bufoff) + ldsw + _i * 8192), 16, 0, 0); } while (0)
#define PG8_LDA(dst, b, h) do { _Pragma("unroll") for (int m = 0; m < 4; ++m) _Pragma("unroll") for (int k = 0; k < 2; ++k) dst[m][k] = *(const PG8_LAS bf16x8*)(lds + PG8_SA(b, h) + aoff + m * 2048 + k * 1024); } while (0)
#define PG8_LDB(dst, b, h) do { _Pragma("unroll") for (int n = 0; n < 2; ++n) _Pragma("unroll") for (int k = 0; k < 2; ++k) dst[n][k] = *(const PG8_LAS bf16x8*)(lds + PG8_SB(b, h) + boff + n * 2048 + k * 1024); } while (0)
#define PG8_MMA(ai, bj, At, Bt) do { __builtin_amdgcn_s_setprio(1); _Pragma("unroll") for (int m = 0; m < 4; ++m) _Pragma("unroll") for (int n = 0; n < 2; ++n) _Pragma("unroll") for (int k = 0; k < 2; ++k) \
        acc[ai][bj][m][n] = __builtin_amdgcn_mfma_f32_16x16x32_bf16(Bt[n][k], At[m][k], acc[ai][bj][m][n], 0, 0, 0); __builtin_amdgcn_s_setprio(0); } while (0)
#define PG8_WAIT_V(n) asm volatile("s_waitcnt vmcnt(" #n ")" ::: "memory")
#define PG8_WAIT_L(n) asm volatile("s_waitcnt lgkmcnt(" #n ")" ::: "memory")
#define PG8_BAR __builtin_amdgcn_s_barrier()
#define PG8_SCHED __builtin_amdgcn_sched_barrier(0)
    Unit cur, nxt; int ui = 0;
    if (!S.next(0, cur)) return;
    f32x4 acc[2][2][4][2];
#pragma unroll
    for (int a = 0; a < 2; ++a)
#pragma unroll
        for (int b = 0; b < 2; ++b)
#pragma unroll
            for (int m = 0; m < 4; ++m)
#pragma unroll
                for (int n = 0; n < 2; ++n) acc[a][b][m][n] = (f32x4){0.f, 0.f, 0.f, 0.f};
    bf16x8 At[4][2], B0[2][2], B1[2][2];
    const char* cA = (const char*)g.A + (size_t)cur.pm * tstep; const char* cB = (const char*)g.Bt + (size_t)cur.pn * tstep;
    S.a_ready(cur);
    PG8_STAGE(PG8_SB(0, 0), cB, voffB); PG8_STAGE(PG8_SA(0, 0), cA, voffA); PG8_STAGE(PG8_SB(0, 1), cB + hstep, voffB); PG8_STAGE(PG8_SA(0, 1), cA + hstep, voffA);
    if (wr == 1) PG8_BAR;
    PG8_WAIT_V(4); PG8_BAR;
    PG8_STAGE(PG8_SB(1, 0), cB + kstep, voffB); PG8_STAGE(PG8_SA(1, 0), cA + kstep, voffA); PG8_STAGE(PG8_SB(1, 1), cB + hstep + kstep, voffB);
    PG8_WAIT_V(6); PG8_BAR;
    for (;;) {
        const bool has_next = S.next(ui + 1, nxt);
        const char* nA = has_next ? (const char*)g.A + (size_t)nxt.pm * tstep : cA; const char* nB = has_next ? (const char*)g.Bt + (size_t)nxt.pn * tstep : cB;
        for (int t = 0; t < nt; t += 2) {
            const bool last = (t == nt - 2);
            const char* a1 = cA + (size_t)(t + 1) * kstep;
            const char* a2 = last ? nA : cA + (size_t)(t + 2) * kstep; const char* b2 = last ? nB : cB + (size_t)(t + 2) * kstep;
            const char* a3 = a2 + kstep; const char* b3 = b2 + kstep;
            if (last && has_next) S.a_ready(nxt);
            PG8_LDB(B0, 0, 0); PG8_SCHED; PG8_LDA(At, 0, 0); PG8_STAGE(PG8_SA(1, 1), a1 + hstep, voffA);
            PG8_WAIT_L(8); PG8_BAR; PG8_WAIT_L(0); PG8_MMA(0, 0, At, B0); PG8_BAR; PG8_SCHED;
            PG8_LDB(B1, 0, 1); PG8_STAGE(PG8_SB(0, 0), b2, voffB);
            PG8_BAR; PG8_WAIT_L(0); PG8_MMA(0, 1, At, B1); PG8_BAR;
            PG8_LDA(At, 0, 1); PG8_STAGE(PG8_SA(0, 0), a2, voffA);
            PG8_BAR; PG8_WAIT_L(0); PG8_MMA(1, 0, At, B0); PG8_BAR; PG8_SCHED;
            PG8_STAGE(PG8_SB(0, 1), b2 + hstep, voffB);
            PG8_WAIT_V(6); PG8_BAR; PG8_MMA(1, 1, At, B1); PG8_BAR;
            PG8_LDB(B0, 1, 0); PG8_SCHED; PG8_LDA(At, 1, 0); PG8_STAGE(PG8_SA(0, 1), a2 + hstep, voffA);
            PG8_WAIT_L(8); PG8_BAR; PG8_WAIT_L(0); PG8_MMA(0, 0, At, B0); PG8_BAR; PG8_SCHED;
            PG8_LDB(B1, 1, 1); PG8_STAGE(PG8_SB(1, 0), b3, voffB);
            PG8_BAR; PG8_WAIT_L(0); PG8_MMA(0, 1, At, B1); PG8_BAR;
            PG8_LDA(At, 1, 1); PG8_STAGE(PG8_SA(1, 0), a3, voffA);
            PG8_BAR; PG8_WAIT_L(0); PG8_MMA(1, 0, At, B0); PG8_BAR; PG8_SCHED;
            PG8_STAGE(PG8_SB(1, 1), b3 + hstep, voffB);
            PG8_WAIT_V(6); PG8_BAR; PG8_MMA(1, 1, At, B1); PG8_BAR;
        }
        if constexpr (!Epi::AFTER_DRAIN) { E(acc, cur, wr, wc, fr, fq); S.done(cur); }
        if (!has_next) break;
#pragma unroll
        for (int a = 0; a < 2; ++a)
#pragma unroll
            for (int b = 0; b < 2; ++b)
#pragma unroll
                for (int m = 0; m < 4; ++m)
#pragma unroll
                    for (int n = 0; n < 2; ++n) acc[a][b][m][n] = (f32x4){0.f, 0.f, 0.f, 0.f};
        cur = nxt; cA = nA; cB = nB; ++ui;
    }
    PG8_WAIT_V(0);
    if (wr == 0) PG8_BAR;
    PG8_BAR;
    if constexpr (Epi::AFTER_DRAIN) { E.fused(acc, cur, wr, wc, fr, fq, lds, wid, lane); S.done(cur); }
#undef PG8_SA
#undef PG8_SB
#undef PG8_STAGE
#undef PG8_LDA
#undef PG8_LDB
#undef PG8_MMA
#undef PG8_WAIT_V
#undef PG8_WAIT_L
#undef PG8_BAR
#undef PG8_SCHED
}
}

struct EpiU {
  static constexpr bool PERM = true, AFTER_DRAIN = false;
  bf16* O;
  __device__ __forceinline__ void operator()(const f32x4 (&acc)[2][2][4][2], const pg8::Unit& u, int wr, int wc, int fr, int fq) const {
    const int row0 = u.pm * 256 + wr * 64 + fr, col0 = u.pn * 256 + wc * 32 + 8 * fq;
#pragma unroll
    for (int ai = 0; ai < 2; ++ai)
#pragma unroll
      for (int m = 0; m < 4; ++m) {
        bf16* rowp = O + (size_t)(row0 + ai * 128 + m * 16) * US + col0;
#pragma unroll
        for (int bj = 0; bj < 2; ++bj) {
          if (col0 + bj * 128 < US) {
            uint4 o;
            o.x = pk2(acc[ai][bj][m][0][0], acc[ai][bj][m][0][1]); o.y = pk2(acc[ai][bj][m][0][2], acc[ai][bj][m][0][3]);
            o.z = pk2(acc[ai][bj][m][1][0], acc[ai][bj][m][1][1]); o.w = pk2(acc[ai][bj][m][1][2], acc[ai][bj][m][1][3]);
            *(uint4*)(rowp + bj * 128) = o;
          }
        }
      }
  }
};
struct EpiF32 {
  static constexpr bool PERM = false, AFTER_DRAIN = false;
  float* C;
  __device__ __forceinline__ void operator()(const f32x4 (&acc)[2][2][4][2], const pg8::Unit& u, int wr, int wc, int fr, int fq) const {
    const int row0 = u.pm * 256 + wr * 64 + fr, col0 = u.pn * 256 + wc * 32 + 4 * fq;
#pragma unroll
    for (int ai = 0; ai < 2; ++ai)
#pragma unroll
      for (int m = 0; m < 4; ++m) {
        float* rowp = C + (size_t)(row0 + ai * 128 + m * 16) * D + col0;
#pragma unroll
        for (int bj = 0; bj < 2; ++bj)
#pragma unroll
          for (int n = 0; n < 2; ++n) *(f32x4*)(rowp + bj * 128 + n * 16) = acc[ai][bj][m][n];
      }
  }
};
struct EpiGU {
  static constexpr bool PERM = true, AFTER_DRAIN = false;
  bf16* O;
  __device__ __forceinline__ void operator()(const f32x4 (&acc)[2][2][4][2], const pg8::Unit& u, int wr, int wc, int fr, int fq) const {
    const int row0 = u.pm * 256 + wr * 64 + fr, col0 = u.pn * 128 + wc * 32 + 8 * fq;
#pragma unroll
    for (int ai = 0; ai < 2; ++ai)
#pragma unroll
      for (int m = 0; m < 4; ++m) {
        bf16* rowp = O + (size_t)(row0 + ai * 128 + m * 16) * FF + col0;
        const f32x4 g0 = acc[ai][0][m][0], g1 = acc[ai][0][m][1], u0 = acc[ai][1][m][0], u1 = acc[ai][1][m][1];
        uint4 o;
        o.x = pk2(silu(g0[0]) * u0[0], silu(g0[1]) * u0[1]); o.y = pk2(silu(g0[2]) * u0[2], silu(g0[3]) * u0[3]);
        o.z = pk2(silu(g1[0]) * u1[0], silu(g1[1]) * u1[1]); o.w = pk2(silu(g1[2]) * u1[2], silu(g1[3]) * u1[3]);
        *(uint4*)rowp = o;
      }
  }
};
template <class Epi>
__device__ __forceinline__ void fast_gemm(char* smem, const bf16* A, const bf16* Bt, int M, int N, int K, const Epi& E) {
  pg8::Gemm g; g.A = A; g.Bt = Bt; g.M = M; g.N = N; g.K = K;
  pg8::StaticOrder S; S.init(M, N, (int)gridDim.x, obid());
  pg8::gemm_phase<Epi, pg8::StaticOrder>((PG8_LAS unsigned char*)smem, g, S, E);
}


__device__ __forceinline__ float ld_sc1(const float* q) { return __hip_atomic_load(q, __ATOMIC_RELAXED, __HIP_MEMORY_SCOPE_AGENT); }
template <bool LAST>
struct EpiFused {
  static constexpr bool PERM = true, AFTER_DRAIN = true;
  bf16* h; float* out; bf16* xn; const float* gpost; const float* gnext; float* ex1; float* ex2; unsigned* cnt1; unsigned* cnt2;
  __device__ __forceinline__ void operator()(const f32x4 (&)[2][2][4][2], const pg8::Unit&, int, int, int, int) const {}
  __device__ __forceinline__ void exchange(const f32x4 (&acc)[2][2][4][2], const pg8::Unit& u, int wr, int wc, int fr, int fq, PG8_LAS float* ssq,
                                           PG8_LAS float* rsv, int tid, float* ex, unsigned* cnt) const {
#pragma unroll
    for (int ai = 0; ai < 2; ++ai)
#pragma unroll
      for (int m = 0; m < 4; ++m) {
        float sv = 0.f;
#pragma unroll
        for (int bj = 0; bj < 2; ++bj)
#pragma unroll
          for (int n = 0; n < 2; ++n) {
            const f32x4 a = acc[ai][bj][m][n];
            sv += a[0] * a[0] + a[1] * a[1] + a[2] * a[2] + a[3] * a[3];
          }
        sv += __shfl_xor(sv, 16); sv += __shfl_xor(sv, 32);
        if (fq == 0) ssq[wc * 256 + ai * 128 + wr * 64 + m * 16 + fr] = sv;
      }
    __syncthreads();
    if (tid < 256) {
      const float t = ssq[tid] + ssq[256 + tid] + ssq[512 + tid] + ssq[768 + tid];
      __hip_atomic_store(ex + (size_t)(u.pm * 4 + u.pn) * 256 + tid, t, __ATOMIC_RELAXED, __HIP_MEMORY_SCOPE_AGENT);
    }
    asm volatile("s_waitcnt vmcnt(0)" ::: "memory");
    __syncthreads();
    if (tid == 0) {
      __builtin_amdgcn_fence(__ATOMIC_RELEASE, "agent");
      asm volatile("s_waitcnt vmcnt(0)" ::: "memory");
      __hip_atomic_fetch_add(cnt + u.pm, 1u, __ATOMIC_RELAXED, __HIP_MEMORY_SCOPE_AGENT);
      unsigned sp = 0;
      while (__hip_atomic_load(cnt + u.pm, __ATOMIC_RELAXED, __HIP_MEMORY_SCOPE_AGENT) < 4u) { __builtin_amdgcn_s_sleep(1); if (++sp > (1u << 22)) break; }
    }
    __syncthreads();
    if (tid < 256) {
      const float* e = ex + (size_t)(u.pm * 4) * 256 + tid;
      const float t = ld_sc1(e) + ld_sc1(e + 256) + ld_sc1(e + 512) + ld_sc1(e + 768);
      rsv[tid] = rsqrtf(t * (1.f / D) + EPS);
    }
    __syncthreads();
  }
  __device__ __forceinline__ void fused(f32x4 (&acc)[2][2][4][2], const pg8::Unit& u, int wr, int wc, int fr, int fq, PG8_LAS unsigned char* lds, int wid,
                                        int lane) const {
    PG8_LAS float* ssq = (PG8_LAS float*)lds;
    PG8_LAS float* rsv = ssq + 1024;
    const int tid = wid * 64 + lane;
    exchange(acc, u, wr, wc, fr, fq, ssq, rsv, tid, ex1, cnt1);
    const int colb = u.pn * 256 + wc * 32 + 8 * fq;
#pragma unroll
    for (int bj = 0; bj < 2; ++bj) {
      const int c = colb + bj * 128;
      const f32x4 gp0 = *(const f32x4*)(gpost + c), gp1 = *(const f32x4*)(gpost + c + 4);
#pragma unroll
      for (int ai = 0; ai < 2; ++ai)
#pragma unroll
        for (int m = 0; m < 4; ++m) {
          const int rl = ai * 128 + wr * 64 + m * 16 + fr;
          int r = u.pm * 256 + rl;
          asm volatile("" : "+v"(r));
          const float rs = rsv[rl];
          const uint4 hb_ = *(const uint4*)(h + (size_t)r * D + c);
          const f32x4 hv0 = f32x4{lo16(hb_.x), hi16(hb_.x), lo16(hb_.y), hi16(hb_.y)};
          const f32x4 hv1 = f32x4{lo16(hb_.z), hi16(hb_.z), lo16(hb_.w), hi16(hb_.w)};
          const f32x4 nv0 = hv0 + acc[ai][bj][m][0] * rs * gp0;
          const f32x4 nv1 = hv1 + acc[ai][bj][m][1] * rs * gp1;
          acc[ai][bj][m][0] = nv0; acc[ai][bj][m][1] = nv1;
          if (!LAST) {
            uint4 ho_; ho_.x = pk2(nv0[0], nv0[1]); ho_.y = pk2(nv0[2], nv0[3]); ho_.z = pk2(nv1[0], nv1[1]); ho_.w = pk2(nv1[2], nv1[3]);
            *(uint4*)(h + (size_t)r * D + c) = ho_;
          } else {
            const int b = r / RB, tt = r % RB + PADB;
            if (tt >= 128) {
              float* op = out + ((size_t)b * SEQ + (tt - 128)) * D + c;
              *(f32x4*)op = nv0; *(f32x4*)(op + 4) = nv1;
            }
          }
        }
    }
    if (LAST) return;
    __syncthreads();
    exchange(acc, u, wr, wc, fr, fq, ssq, rsv, tid, ex2, cnt2);
#pragma unroll
    for (int bj = 0; bj < 2; ++bj) {
      const int c = colb + bj * 128;
      const f32x4 gn0 = *(const f32x4*)(gnext + c), gn1 = *(const f32x4*)(gnext + c + 4);
#pragma unroll
      for (int ai = 0; ai < 2; ++ai)
#pragma unroll
        for (int m = 0; m < 4; ++m) {
          const int rl = ai * 128 + wr * 64 + m * 16 + fr;
          int r = u.pm * 256 + rl;
          asm volatile("" : "+v"(r));
          const float rs = rsv[rl];
          const f32x4 v0 = acc[ai][bj][m][0] * rs * gn0, v1 = acc[ai][bj][m][1] * rs * gn1;
          uint4 o; o.x = pk2(v0[0], v0[1]); o.y = pk2(v0[2], v0[3]); o.z = pk2(v1[0], v1[1]); o.w = pk2(v1[2], v1[3]);
          *(uint4*)(xn + (size_t)r * D + c) = o;
        }
    }
  }
};

__device__ void left_gemm_f32(const bf16* A, int lda, const bf16* Bt, int K, int cb, float* outp, char* smem) {
  const int tid = otid(), lane = tid & 63, w = tid >> 6, r = lane & 15, q4 = lane >> 4;
  float* red = (float*)smem;
  f32x4 acc[2][2];
#pragma unroll
  for (int i = 0; i < 2; ++i)
#pragma unroll
    for (int j = 0; j < 2; ++j) acc[i][j] = f32x4{0.f, 0.f, 0.f, 0.f};
  const int kc = K / 8, kbeg = w * kc;
  const bf16* ap = A + (size_t)(LROW0 + r) * lda + kbeg + q4 * 8;
  const bf16* bp = Bt + (size_t)(cb * 32 + r) * K + kbeg + q4 * 8;
  __syncthreads();
  for (int k = 0; k < kc; k += 32) {
    bf16x8 a[2], bb[2];
#pragma unroll
    for (int i = 0; i < 2; ++i) { a[i] = *(const bf16x8*)(ap + (size_t)(16 * i) * lda + k); bb[i] = *(const bf16x8*)(bp + (size_t)(16 * i) * K + k); }
#pragma unroll
    for (int i = 0; i < 2; ++i)
#pragma unroll
      for (int j = 0; j < 2; ++j) acc[i][j] = MFMA(a[i], bb[j], acc[i][j]);
  }
#pragma unroll
  for (int i = 0; i < 2; ++i)
#pragma unroll
    for (int j = 0; j < 2; ++j)
#pragma unroll
      for (int jj = 0; jj < 4; ++jj) red[w * 1024 + (16 * i + 4 * q4 + jj) * 32 + 16 * j + r] = acc[i][j][jj];
  __syncthreads();
#pragma unroll
  for (int e = 0; e < 2; ++e) {
    const int idx = tid + e * NT, row = idx >> 5, col = idx & 31;
    float t = 0.f;
#pragma unroll
    for (int ww = 0; ww < 8; ++ww) t += red[ww * 1024 + idx];
    outp[(size_t)(LROW0 + row) * D + cb * 32 + col] = t;
  }
}
__device__ void left_merge(const P& p, int layer, int cb, char* smem) {
  const int tid = otid(), lane = tid & 63, w = tid >> 6, r = lane & 15, q4 = lane >> 4;
  float* red = (float*)smem;
  f32x4 acc[2][2];
#pragma unroll
  for (int i = 0; i < 2; ++i)
#pragma unroll
    for (int j = 0; j < 2; ++j) acc[i][j] = f32x4{0.f, 0.f, 0.f, 0.f};
  const int br = w >> 1, kh = (w & 1) * 128;
  const bf16* ap = p.y() + (size_t)(LROW0 + r) * D + br * 256 + kh + q4 * 8;
  const bf16* bp = p.Wb_t() + (size_t)br * 1024 * 256 + (size_t)(cb * 32 + r) * 256 + kh + q4 * 8;
  __syncthreads();
#pragma unroll
  for (int k = 0; k < 128; k += 32) {
    bf16x8 a[2], bb[2];
#pragma unroll
    for (int i = 0; i < 2; ++i) { a[i] = *(const bf16x8*)(ap + (size_t)(16 * i) * D + k); bb[i] = *(const bf16x8*)(bp + (size_t)(16 * i) * 256 + k); }
#pragma unroll
    for (int i = 0; i < 2; ++i)
#pragma unroll
      for (int j = 0; j < 2; ++j) acc[i][j] = MFMA(a[i], bb[j], acc[i][j]);
  }
#pragma unroll
  for (int i = 0; i < 2; ++i)
#pragma unroll
    for (int j = 0; j < 2; ++j)
#pragma unroll
      for (int jj = 0; jj < 4; ++jj) red[w * 1024 + (16 * i + 4 * q4 + jj) * 32 + 16 * j + r] = acc[i][j][jj];
  __syncthreads();
#pragma unroll
  for (int e = 0; e < 2; ++e) {
    const int idx = tid + e * NT, row = idx >> 5, col = cb * 32 + (idx & 31);
    const size_t prow = (size_t)(LROW0 + row);
    float t = 0.f;
#pragma unroll
    for (int b4 = 0; b4 < 4; ++b4) {
      const float z = red[(2 * b4) * 1024 + idx] + red[(2 * b4 + 1) * 1024 + idx];
      const float lg = bf2f(p.U()[prow * US + C_MG + b4 * 1024 + col]) + p.b_merge[((size_t)layer * 4 + b4) * 1024 + col];
      t += sigm(lg) * z;
    }
    p.xn()[prow * D + col] = f2bf(t);
  }
}

__device__ void sb_unit(const P& p, int unit, char* smem) {
  const int tid = otid(), lane = tid & 63, w = tid >> 6, r = lane & 15, q4 = lane >> 4;
  const int qb = unit % NCH, bh = unit / NCH, h = bh & 3, b = bh >> 2;
  bf16* Ks = (bf16*)smem;
  bf16* Vt = Ks + 64 * 72;
  const int sq = qb * 128 + 16 * w + r;
  bf16x8 qf[2];
  {
    const bf16* qp = p.U() + rowof(b, sq) * US + C_SBQ + h * 64 + q4 * 8;
    qf[0] = *(const bf16x8*)qp;
    qf[1] = *(const bf16x8*)(qp + 32);
  }
  f32x4 o[4];
#pragma unroll
  for (int i = 0; i < 4; ++i) o[i] = f32x4{0.f, 0.f, 0.f, 0.f};
  float R = 0.f;
  for (int jt = 2 * qb + 1; jt >= 1; --jt) {
    __syncthreads();
    {
      const int keyk = tid >> 3, ck = (tid & 7) * 8;
      const uint4 kv = *(const uint4*)(p.U() + rowof(b, jt * 64 + keyk) * US + C_SBK + h * 64 + ck);
      const int key = tid & 63, c0 = (tid >> 6) * 8;
      const uint4 vv = *(const uint4*)(p.U() + rowof(b, jt * 64 + key) * US + C_SBV + h * 64 + c0);
      *(uint4*)(Ks + keyk * 72 + ck) = kv;
      Vt[(c0 + 0) * 72 + key] = (bf16)(vv.x & 0xffffu); Vt[(c0 + 1) * 72 + key] = (bf16)(vv.x >> 16);
      Vt[(c0 + 2) * 72 + key] = (bf16)(vv.y & 0xffffu); Vt[(c0 + 3) * 72 + key] = (bf16)(vv.y >> 16);
      Vt[(c0 + 4) * 72 + key] = (bf16)(vv.z & 0xffffu); Vt[(c0 + 5) * 72 + key] = (bf16)(vv.z >> 16);
      Vt[(c0 + 6) * 72 + key] = (bf16)(vv.w & 0xffffu); Vt[(c0 + 7) * 72 + key] = (bf16)(vv.w >> 16);
    }
    __syncthreads();
    f32x4 s[4];
#pragma unroll
    for (int mt = 0; mt < 4; ++mt) {
      s[mt] = f32x4{0.f, 0.f, 0.f, 0.f};
#pragma unroll
      for (int kb = 0; kb < 2; ++kb) {
        const bf16x8 a = *(const bf16x8*)(Ks + (16 * mt + r) * 72 + kb * 32 + q4 * 8);
        s[mt] = MFMA(a, qf[kb], s[mt]);
      }
    }
    float T[4];
    f32x4 cs[4];
#pragma unroll
    for (int mt = 0; mt < 4; ++mt) {
      float sp[4];
#pragma unroll
      for (int j = 0; j < 4; ++j) {
        const int sk = jt * 64 + 16 * mt + 4 * q4 + j;
        const bool ok = (sk < sq) && (sk >= 112);
        const float z = s[mt][j] * 0.125f;
        s[mt][j] = ok ? z : -1e30f;
        sp[j] = ok ? softplus(z) : 0.f;
      }
      const float c3 = sp[3], c2 = sp[2] + c3, c1 = sp[1] + c2, c0 = sp[0] + c1;
      const float p1 = __shfl_xor(c0, 16);
      const float pair = c0 + p1;
      const float p2 = __shfl_xor(pair, 32);
      const float above = ((q4 & 1) == 0 ? p1 : 0.f) + ((q4 & 2) == 0 ? p2 : 0.f);
      T[mt] = pair + p2;
      cs[mt][0] = c0 + above; cs[mt][1] = c1 + above; cs[mt][2] = c2 + above; cs[mt][3] = c3 + above;
    }
    float offs[4];
    offs[3] = R; offs[2] = offs[3] + T[3]; offs[1] = offs[2] + T[2]; offs[0] = offs[1] + T[1];
    R = offs[0] + T[0];
    f32x4 a[4];
#pragma unroll
    for (int mt = 0; mt < 4; ++mt)
#pragma unroll
      for (int j = 0; j < 4; ++j) a[mt][j] = __expf(s[mt][j] - (cs[mt][j] + offs[mt]));
#pragma unroll
    for (int kb2 = 0; kb2 < 2; ++kb2) {
      union { bf16x8 v; unsigned u[4]; } pb;
      pb.u[0] = pk2(a[2 * kb2][0], a[2 * kb2][1]); pb.u[1] = pk2(a[2 * kb2][2], a[2 * kb2][3]);
      pb.u[2] = pk2(a[2 * kb2 + 1][0], a[2 * kb2 + 1][1]); pb.u[3] = pk2(a[2 * kb2 + 1][2], a[2 * kb2 + 1][3]);
#pragma unroll
      for (int et = 0; et < 4; ++et) {
        const bf16* vp = Vt + (16 * et + r) * 72 + 32 * kb2 + 4 * q4;
        union { bf16x8 v; uint2 u[2]; } va;
        va.u[0] = *(const uint2*)vp;
        va.u[1] = *(const uint2*)(vp + 16);
        o[et] = MFMA(va.v, pb.v, o[et]);
      }
    }
    if (__syncthreads_and(R > 64.f)) break;
  }
  bf16* yp = p.y() + rowof(b, sq) * D + 0 * 256 + h * 64 + 4 * q4;
#pragma unroll
  for (int et = 0; et < 4; ++et) {
    uint2 ov; ov.x = pk2(o[et][0], o[et][1]); ov.y = pk2(o[et][2], o[et][3]);
    *(uint2*)(yp + 16 * et) = ov;
  }
}

template <int DK, int NE>
__device__ __forceinline__ void local_mfma(const bf16* KxT, const bf16* VxT, float* outc, float* outn) {
  const int tid = otid(), lane = tid & 63, w = tid >> 6, r = lane & 15, q = lane >> 4;
  constexpr int NT_ = (DK / 16) * NE;
#pragma unroll
  for (int ti = 0; ti < (NT_ + 7) / 8; ++ti) {
    const int tl = w + 8 * ti;
    if (tl < NT_) {
      const int dt = tl / NE, et = tl % NE;
      f32x4 acc = f32x4{0.f, 0.f, 0.f, 0.f};
#pragma unroll
      for (int k0 = 0; k0 < 128; k0 += 32) {
        const bf16x8 a = *(const bf16x8*)(KxT + (16 * dt + r) * 136 + k0 + q * 8);
        const bf16x8 bv = *(const bf16x8*)(VxT + (16 * et + r) * 136 + k0 + q * 8);
        acc = MFMA(a, bv, acc);
      }
      if (et < 4) {
#pragma unroll
        for (int j = 0; j < 4; ++j) outc[(16 * dt + 4 * q + j) * 64 + 16 * et + r] = acc[j];
      } else if (r == 0) {
#pragma unroll
        for (int j = 0; j < 4; ++j) outn[16 * dt + 4 * q + j] = acc[j];
      }
    }
  }
}

__device__ __forceinline__ void load_vxT(const bf16* vsrc, bf16* VxT, int c, int rbase, int rpad) {
  const int tid = otid(), e0 = (tid >> 7) * 16, t = tid & 127;
  const bf16* vs = vsrc + TROW(t) * US + e0;
  const uint4 v0 = *(const uint4*)vs, v1 = *(const uint4*)(vs + 8);
  VxT[(e0 + 0) * 136 + t] = (bf16)(v0.x & 0xffffu); VxT[(e0 + 1) * 136 + t] = (bf16)(v0.x >> 16);
  VxT[(e0 + 2) * 136 + t] = (bf16)(v0.y & 0xffffu); VxT[(e0 + 3) * 136 + t] = (bf16)(v0.y >> 16);
  VxT[(e0 + 4) * 136 + t] = (bf16)(v0.z & 0xffffu); VxT[(e0 + 5) * 136 + t] = (bf16)(v0.z >> 16);
  VxT[(e0 + 6) * 136 + t] = (bf16)(v0.w & 0xffffu); VxT[(e0 + 7) * 136 + t] = (bf16)(v0.w >> 16);
  VxT[(e0 + 8) * 136 + t] = (bf16)(v1.x & 0xffffu); VxT[(e0 + 9) * 136 + t] = (bf16)(v1.x >> 16);
  VxT[(e0 + 10) * 136 + t] = (bf16)(v1.y & 0xffffu); VxT[(e0 + 11) * 136 + t] = (bf16)(v1.y >> 16);
  VxT[(e0 + 12) * 136 + t] = (bf16)(v1.z & 0xffffu); VxT[(e0 + 13) * 136 + t] = (bf16)(v1.z >> 16);
  VxT[(e0 + 14) * 136 + t] = (bf16)(v1.w & 0xffffu); VxT[(e0 + 15) * 136 + t] = (bf16)(v1.w >> 16);
}

__device__ void gla_prep_unit(const P& p, int layer, int unit, char* smem) {
  const int tid = otid(), lane = tid & 63, w = tid >> 6;
  const int c = unit % NCH, bh = unit / NCH, h = bh & 3, b = bh >> 2;
  float* la = (float*)smem;
  float* cl = la + 128 * 33;
  bf16* KxT = (bf16*)(cl + 32);
  bf16* VxT = KxT + 32 * 136;
  const int rbase = b * RB + c * 128 - PADB, rpad = RREAL + b * PADB;
  uint4 qv_pre, kv_pre;
  {
    const int t = tid >> 2, d0 = (tid & 3) * 8;
    qv_pre = *(const uint4*)(p.U() + TROW(t) * US + C_GQ + h * 32 + d0);
    kv_pre = *(const uint4*)(p.U() + TROW(t) * US + C_GK + h * 32 + d0);
  }
  __syncthreads();
  {
    const int t = tid >> 2, d0 = (tid & 3) * 8;
    const bf16* cp = p.U() + TROW(t) * US + C_GC;
    const uint4 c0 = *(const uint4*)cp, c1 = *(const uint4*)(cp + 8);
    float cv[16];
    { float f[8]; UNPK8(c0, f);
#pragma unroll
      for (int i = 0; i < 8; ++i) cv[i] = f[i];
      UNPK8(c1, f);
#pragma unroll
      for (int i = 0; i < 8; ++i) cv[8 + i] = f[i]; }
    const float* wg = p.gla_wg + (size_t)layer * 16 * 128 + h * 32 + d0;
    float acc[8];
    {
      const float4 b0 = *(const float4*)(p.gla_bg + layer * 128 + h * 32 + d0), b1 = *(const float4*)(p.gla_bg + layer * 128 + h * 32 + d0 + 4);
      acc[0] = b0.x; acc[1] = b0.y; acc[2] = b0.z; acc[3] = b0.w; acc[4] = b1.x; acc[5] = b1.y; acc[6] = b1.z; acc[7] = b1.w;
    }
#pragma unroll
    for (int rr = 0; rr < 16; ++rr) {
      const float4 w0 = *(const float4*)(wg + rr * 128), w1 = *(const float4*)(wg + rr * 128 + 4);
      acc[0] += cv[rr] * w0.x; acc[1] += cv[rr] * w0.y; acc[2] += cv[rr] * w0.z; acc[3] += cv[rr] * w0.w;
      acc[4] += cv[rr] * w1.x; acc[5] += cv[rr] * w1.y; acc[6] += cv[rr] * w1.z; acc[7] += cv[rr] * w1.w;
    }
#pragma unroll
    for (int i = 0; i < 8; ++i) la[t * 33 + d0 + i] = logsig(acc[i]) * (1.f / 16.f);
  }
  __syncthreads();
#pragma unroll
  for (int i = 0; i < 4; ++i) {
    const int d = 4 * w + i;
    const float v0 = la[(2 * lane) * 33 + d], v1 = la[(2 * lane + 1) * 33 + d];
    const float s = v0 + v1;
    const float incl = scan_add(s, lane);
    la[(2 * lane) * 33 + d] = incl - s + v0;
    la[(2 * lane + 1) * 33 + d] = incl;
    if (lane == 63) cl[d] = incl;
  }
  __syncthreads();
  {
    const int t = tid >> 2, d0 = (tid & 3) * 8;
    bf16* qp = p.U() + TROW(t) * US + C_GQ + h * 32 + d0;
    bf16* kp = p.U() + TROW(t) * US + C_GK + h * 32 + d0;
    const uint4 qv = qv_pre, kv = kv_pre;
    float qf[8], kf[8], qd[8], kd[8], kx8[8];
    UNPK8(qv, qf); UNPK8(kv, kf);
#pragma unroll
    for (int i = 0; i < 8; ++i) {
      const float cum = la[t * 33 + d0 + i];
      qd[i] = qf[i] * 0.17677669529663687f * __expf(cum);
      kd[i] = kf[i] * __expf(-cum);
      kx8[i] = kf[i] * __expf(cl[d0 + i] - cum);
    }
#pragma unroll
    for (int i = 0; i < 8; ++i) KxT[(d0 + i) * 136 + t] = f2bf(kx8[i]);
    uint4 qo, ko;
    qo.x = pk2(qd[0], qd[1]); qo.y = pk2(qd[2], qd[3]); qo.z = pk2(qd[4], qd[5]); qo.w = pk2(qd[6], qd[7]);
    ko.x = pk2(kd[0], kd[1]); ko.y = pk2(kd[2], kd[3]); ko.z = pk2(kd[4], kd[5]); ko.w = pk2(kd[6], kd[7]);
    *(uint4*)qp = qo; *(uint4*)kp = ko;
    load_vxT(p.U() + C_GV + h * 64, VxT, c, rbase, rpad);
  }
  __syncthreads();
  local_mfma<32, 4>(KxT, VxT, p.gla_loc() + (size_t)unit * 2048, nullptr);
  if (tid < 32) p.gla_dec()[unit * 32 + tid] = __expf(cl[tid]);
}

__device__ void ml_prep_unit(const P& p, int layer, int unit, char* smem) {
  const int tid = otid(), lane = tid & 63, w = tid >> 6;
  const int c = unit % NCH, bh = unit / NCH, h = bh & 3, b = bh >> 2;
  bf16* KxT = (bf16*)smem;
  bf16* VxT = KxT + 64 * 136;
  float* pe = (float*)(VxT + 80 * 136);
  const int rbase = b * RB + c * 128 - PADB, rpad = RREAL + b * PADB;
  uint4 cx[4][4];
  {
    const int t = tid >> 2, d0 = (tid & 3) * 16;
    const int sidx = c * 128 + t;
#pragma unroll
    for (int j = 0; j < 4; ++j) {
      const int ts = sidx - 3 + j;
      const bf16* xp = p.U() + rowof(b, ts >= 0 ? ts : 0) * US + C_MQK + h * 64 + d0;
      cx[j][0] = *(const uint4*)xp; cx[j][1] = *(const uint4*)(xp + 8); cx[j][2] = *(const uint4*)(xp + 256); cx[j][3] = *(const uint4*)(xp + 264);
    }
  }
  __syncthreads();
  if (w == 0) {
    const int t0 = 2 * lane, t1 = t0 + 1;
    const float bi = p.ml_bi[layer * 4 + h], bff = p.ml_bf[layer * 4 + h];
    const float li0 = bf2f(p.U()[TROW(t0) * US + C_MI + h]) + bi, li1 = bf2f(p.U()[TROW(t1) * US + C_MI + h]) + bi;
    const float lf0 = logsig(bf2f(p.U()[TROW(t0) * US + C_MF + h]) + bff), lf1 = logsig(bf2f(p.U()[TROW(t1) * US + C_MF + h]) + bff);
    const float s = lf0 + lf1;
    const float incl = scan_add(s, lane);
    const float cf0 = incl - s + lf0, cf1 = incl;
    const float cum_last = __shfl(incl, 63);
    const float g0 = li0 - cf0, g1 = li1 - cf1;
    const float mx = fmaxf(g0, g1);
    const float inclm = scan_max(mx, lane);
    float exm = __shfl_up(inclm, 1);
    if (lane == 0) exm = -3.0e38f;
    const float pm0 = fmaxf(exm, g0), pm1 = inclm;
    const float gmax = __shfl(inclm, 63);
    pe[t0] = __expf(g0 - gmax); pe[t1] = __expf(g1 - gmax);
    p.ml_g()[TROW(t0) * 4 + h] = g0; p.ml_g()[TROW(t1) * 4 + h] = g1;
    p.ml_pm()[TROW(t0) * 4 + h] = pm0; p.ml_pm()[TROW(t1) * 4 + h] = pm1;
    p.ml_cf()[TROW(t0) * 4 + h] = cf0; p.ml_cf()[TROW(t1) * 4 + h] = cf1;
    if (lane == 0) { p.ml_fl()[unit] = cum_last; p.ml_al()[unit] = cum_last + gmax; }
  }
  __syncthreads();
  {
    const int t = tid >> 2, d0 = (tid & 3) * 16;
    const int sidx = c * 128 + t;
    float aq[16], ak[16];
#pragma unroll
    for (int i = 0; i < 16; ++i) { aq[i] = 0.f; ak[i] = 0.f; }
#pragma unroll
    for (int j = 0; j < 4; ++j) {
      const int ts = sidx - 3 + j;
      if (ts >= 0) {
        const float* wq = p.ml_conv + ((size_t)layer * 4 + j) * 512 + h * 64 + d0;
        const uint4 x0 = cx[j][0], x1 = cx[j][1], x2 = cx[j][2], x3 = cx[j][3];
        float f[8], wv[8];
#define LDW8(ptr) { const float4 w0_ = *(const float4*)(ptr), w1_ = *(const float4*)((ptr) + 4); wv[0] = w0_.x; wv[1] = w0_.y; wv[2] = w0_.z; wv[3] = w0_.w; wv[4] = w1_.x; wv[5] = w1_.y; wv[6] = w1_.z; wv[7] = w1_.w; }
        UNPK8(x0, f); LDW8(wq)
#pragma unroll
        for (int i = 0; i < 8; ++i) aq[i] += f[i] * wv[i];
        UNPK8(x1, f); LDW8(wq + 8)
#pragma unroll
        for (int i = 0; i < 8; ++i) aq[8 + i] += f[i] * wv[i];
        UNPK8(x2, f); LDW8(wq + 256)
#pragma unroll
        for (int i = 0; i < 8; ++i) ak[i] += f[i] * wv[i];
        UNPK8(x3, f); LDW8(wq + 264)
#pragma unroll
        for (int i = 0; i < 8; ++i) ak[8 + i] += f[i] * wv[i];
#undef LDW8
      }
    }
    const float pet = pe[t];
#pragma unroll
    for (int i = 0; i < 16; ++i) {
      aq[i] = silu(aq[i]);
      ak[i] = silu(ak[i]) * 0.125f;
    }
#pragma unroll
    for (int i = 0; i < 16; ++i) KxT[(d0 + i) * 136 + t] = f2bf(pet * ak[i]);
    bf16* dq = p.mlqk() + TROW(t) * 512 + h * 128 + d0;
    uint4 o;
    o.x = pk2(aq[0], aq[1]); o.y = pk2(aq[2], aq[3]); o.z = pk2(aq[4], aq[5]); o.w = pk2(aq[6], aq[7]);
    *(uint4*)dq = o;
    o.x = pk2(aq[8], aq[9]); o.y = pk2(aq[10], aq[11]); o.z = pk2(aq[12], aq[13]); o.w = pk2(aq[14], aq[15]);
    *(uint4*)(dq + 8) = o;
    o.x = pk2(ak[0], ak[1]); o.y = pk2(ak[2], ak[3]); o.z = pk2(ak[4], ak[5]); o.w = pk2(ak[6], ak[7]);
    *(uint4*)(dq + 64) = o;
    o.x = pk2(ak[8], ak[9]); o.y = pk2(ak[10], ak[11]); o.z = pk2(ak[12], ak[13]); o.w = pk2(ak[14], ak[15]);
    *(uint4*)(dq + 72) = o;
    load_vxT(p.U() + C_MV + h * 64, VxT, c, rbase, rpad);
    if (tid < 128) {
      VxT[64 * 136 + tid] = (bf16)0x3F80;
#pragma unroll
      for (int i = 65; i < 80; ++i) VxT[i * 136 + tid] = 0;
    }
  }
  __syncthreads();
  local_mfma<64, 5>(KxT, VxT, p.ml_c() + (size_t)unit * 4096, p.ml_n() + (size_t)unit * 64);
}

__device__ void ret_prep_unit(const P& p, int layer, int unit, char* smem) {
  const int tid = otid();
  const int c = unit % NCH, bh = unit / NCH, h = bh & 3, b = bh >> 2;
  bf16* KxT = (bf16*)smem;
  bf16* VxT = KxT + 64 * 136;
  const int rbase = b * RB + c * 128 - PADB, rpad = RREAL + b * PADB;
  const float l2g = __log2f(1.f - exp2f(-5.f - (float)h));
  __syncthreads();
  {
    const int t = tid >> 2, i0 = (tid & 3) * 8;
    const int sidx = c * 128 + t;
    const float4 ca = *(const float4*)(p.rope_cos() + sidx * 32 + i0), cb = *(const float4*)(p.rope_cos() + sidx * 32 + i0 + 4);
    const float4 sa = *(const float4*)(p.rope_sin() + sidx * 32 + i0), sb = *(const float4*)(p.rope_sin() + sidx * 32 + i0 + 4);
    const float cs[8] = {ca.x, ca.y, ca.z, ca.w, cb.x, cb.y, cb.z, cb.w};
    const float sn[8] = {sa.x, sa.y, sa.z, sa.w, sb.x, sb.y, sb.z, sb.w};
    bf16* qp = p.U() + TROW(t) * US + C_RQ + h * 64 + i0;
    bf16* kp = p.U() + TROW(t) * US + C_RK + h * 64 + i0;
    const uint4 q1 = *(const uint4*)qp, q2 = *(const uint4*)(qp + 32), k1 = *(const uint4*)kp, k2 = *(const uint4*)(kp + 32);
    float a[8], bb[8], o1[8], o2[8];
    UNPK8(q1, a); UNPK8(q2, bb);
#pragma unroll
    for (int i = 0; i < 8; ++i) { o1[i] = a[i] * cs[i] - bb[i] * sn[i]; o2[i] = a[i] * sn[i] + bb[i] * cs[i]; }
    uint4 o;
    o.x = pk2(o1[0], o1[1]); o.y = pk2(o1[2], o1[3]); o.z = pk2(o1[4], o1[5]); o.w = pk2(o1[6], o1[7]);
    *(uint4*)qp = o;
    o.x = pk2(o2[0], o2[1]); o.y = pk2(o2[2], o2[3]); o.z = pk2(o2[4], o2[5]); o.w = pk2(o2[6], o2[7]);
    *(uint4*)(qp + 32) = o;
    UNPK8(k1, a); UNPK8(k2, bb);
    const float kdec = exp2f((float)(127 - t) * l2g);
#pragma unroll
    for (int i = 0; i < 8; ++i) {
      o1[i] = (a[i] * cs[i] - bb[i] * sn[i]) * 0.125f; o2[i] = (a[i] * sn[i] + bb[i] * cs[i]) * 0.125f;
    }
#pragma unroll
    for (int i = 0; i < 8; ++i) { KxT[(i0 + i) * 136 + t] = f2bf(o1[i] * kdec); KxT[(32 + i0 + i) * 136 + t] = f2bf(o2[i] * kdec); }
    o.x = pk2(o1[0], o1[1]); o.y = pk2(o1[2], o1[3]); o.z = pk2(o1[4], o1[5]); o.w = pk2(o1[6], o1[7]);
    *(uint4*)kp = o;
    o.x = pk2(o2[0], o2[1]); o.y = pk2(o2[2], o2[3]); o.z = pk2(o2[4], o2[5]); o.w = pk2(o2[6], o2[7]);
    *(uint4*)(kp + 32) = o;
    load_vxT(p.U() + C_RV + h * 64, VxT, c, rbase, rpad);
  }
  __syncthreads();
  local_mfma<64, 4>(KxT, VxT, p.ret_loc() + (size_t)unit * 4096, nullptr);
}

__device__ void phase_scan(const P& p) {
  const int g = blockIdx.x * NT + otid();
  constexpr int N_GLA = 8 * 2048, N_ML = 8 * 4160, N_RET = 8 * 4096;
  constexpr int SB_ = 13, NBAT = NCH / SB_;
  if (g < N_GLA) {
    const int bh = g / 2048, de = g % 2048, d = de >> 6;
    float* base = p.gla_loc() + (size_t)bh * NCH * 2048 + de;
    const float* db = p.gla_dec() + (size_t)bh * NCH * 32 + d;
    float st = 0.f;
#pragma unroll 1
    for (int bt = 0; bt < NBAT; ++bt) {
      float loc[SB_], dec[SB_];
#pragma unroll
      for (int n = 0; n < SB_; ++n) { loc[n] = base[(size_t)n * 2048]; dec[n] = db[n * 32]; }
#pragma unroll
      for (int n = 0; n < SB_; ++n) { base[(size_t)n * 2048] = st; st = dec[n] * st + loc[n]; }
      base += (size_t)SB_ * 2048; db += SB_ * 32;
    }
  } else if (g < N_GLA + N_ML) {
    const int gg = g - N_GLA;
    const int bh = gg / 4160, idx = gg % 4160;
    float* base = (idx < 4096) ? (p.ml_c() + (size_t)bh * NCH * 4096 + idx) : (p.ml_n() + (size_t)bh * NCH * 64 + (idx - 4096));
    const int stride = (idx < 4096) ? 4096 : 64;
    float st = 0.f, m = 0.f;
    int unit = bh * NCH;
#pragma unroll 1
    for (int bt = 0; bt < NBAT; ++bt) {
      float loc[SB_], fl[SB_], al[SB_];
#pragma unroll
      for (int n = 0; n < SB_; ++n) { loc[n] = base[(size_t)n * stride]; fl[n] = p.ml_fl()[unit + n]; al[n] = p.ml_al()[unit + n]; }
#pragma unroll
      for (int n = 0; n < SB_; ++n) {
        const float mn = fmaxf(fl[n] + m, al[n]);
        const float sp = __expf(fl[n] + m - mn), sl = __expf(al[n] - mn);
        base[(size_t)n * stride] = st;
        st = sp * st + sl * loc[n];
        if (idx == 0) p.ml_mprev()[unit + n] = m;
        m = mn;
      }
      base += (size_t)SB_ * stride; unit += SB_;
    }
  } else if (g < N_GLA + N_ML + N_RET) {
    const int gg = g - N_GLA - N_ML;
    const int bh = gg / 4096, de = gg % 4096, h = bh & 3;
    const float dec = exp2f(128.f * __log2f(1.f - exp2f(-5.f - (float)h)));
    float* base = p.ret_loc() + (size_t)bh * NCH * 4096 + de;
    float st = 0.f;
#pragma unroll 1
    for (int bt = 0; bt < NBAT; ++bt) {
      float loc[SB_];
#pragma unroll
      for (int n = 0; n < SB_; ++n) loc[n] = base[(size_t)n * 4096];
#pragma unroll
      for (int n = 0; n < SB_; ++n) { base[(size_t)n * 4096] = st; st = dec * st + loc[n]; }
      base += (size_t)SB_ * 4096;
    }
  }
}

template <int MX>
__device__ void out_unit(const P& p, int layer, int unit, char* smem) {
  constexpr int DK = (MX == 0) ? 32 : 64;
  constexpr int NE = (MX == 1) ? 5 : 4;
  const int tid = otid(), lane = tid & 63, w = tid >> 6, r = lane & 15, q4 = lane >> 4;
  const int c = unit % NCH, bh = unit / NCH, h = bh & 3, b = bh >> 2;
  bf16* Qs = (bf16*)smem;
  bf16* Ks = Qs + 128 * 72;
  bf16* Vt = Ks + 128 * 72;
  bf16* Ss = Vt + 80 * 136;
  bf16* St = Ss + 128 * 136;
  float* va = (float*)(St + 80 * 72);
  float* vb = va + 128;
  float* vc = vb + 128;
  const int rbase = b * RB + c * 128 - PADB, rpad = RREAL + b * PADB;
  const float l2g = __log2f(1.f - exp2f(-5.f - (float)h));
  float mprev = 0.f;
  constexpr int GC = (MX == 0) ? C_GR : (MX == 1 ? C_MO : C_RG);
  uint2 gpre[4];
  {
    const bf16* gp = p.U() + TROW(16 * w + r) * US + GC + h * 64 + 4 * q4;
#pragma unroll
    for (int et = 0; et < 4; ++et) gpre[et] = *(const uint2*)(gp + 16 * et);
  }
  __syncthreads();
  {
    const int t = tid >> 2;
    if (MX == 0) {
      const int d0 = (tid & 3) * 8;
      *(uint4*)(Qs + t * 72 + d0) = *(const uint4*)(p.U() + TROW(t) * US + C_GQ + h * 32 + d0);
      *(uint4*)(Ks + t * 72 + d0) = *(const uint4*)(p.U() + TROW(t) * US + C_GK + h * 32 + d0);
    } else {
      const int d0 = (tid & 3) * 16;
      const bf16* qs = (MX == 1) ? (p.mlqk() + TROW(t) * 512 + h * 128 + d0) : (p.U() + TROW(t) * US + C_RQ + h * 64 + d0);
      const bf16* ks = (MX == 1) ? (p.mlqk() + TROW(t) * 512 + h * 128 + 64 + d0) : (p.U() + TROW(t) * US + C_RK + h * 64 + d0);
      *(uint4*)(Qs + t * 72 + d0) = *(const uint4*)qs;
      *(uint4*)(Qs + t * 72 + d0 + 8) = *(const uint4*)(qs + 8);
      *(uint4*)(Ks + t * 72 + d0) = *(const uint4*)ks;
      *(uint4*)(Ks + t * 72 + d0 + 8) = *(const uint4*)(ks + 8);
    }
    {
      const int e0 = (tid >> 7) * 16;
      const int t = tid & 127;
      constexpr int VC = (MX == 0) ? C_GV : (MX == 1 ? C_MV : C_RV);
      const bf16* vs = p.U() + TROW(t) * US + VC + h * 64 + e0;
      const uint4 v0 = *(const uint4*)vs, v1 = *(const uint4*)(vs + 8);
      Vt[(e0 + 0) * 136 + t] = (bf16)(v0.x & 0xffffu); Vt[(e0 + 1) * 136 + t] = (bf16)(v0.x >> 16);
      Vt[(e0 + 2) * 136 + t] = (bf16)(v0.y & 0xffffu); Vt[(e0 + 3) * 136 + t] = (bf16)(v0.y >> 16);
      Vt[(e0 + 4) * 136 + t] = (bf16)(v0.z & 0xffffu); Vt[(e0 + 5) * 136 + t] = (bf16)(v0.z >> 16);
      Vt[(e0 + 6) * 136 + t] = (bf16)(v0.w & 0xffffu); Vt[(e0 + 7) * 136 + t] = (bf16)(v0.w >> 16);
      Vt[(e0 + 8) * 136 + t] = (bf16)(v1.x & 0xffffu); Vt[(e0 + 9) * 136 + t] = (bf16)(v1.x >> 16);
      Vt[(e0 + 10) * 136 + t] = (bf16)(v1.y & 0xffffu); Vt[(e0 + 11) * 136 + t] = (bf16)(v1.y >> 16);
      Vt[(e0 + 12) * 136 + t] = (bf16)(v1.z & 0xffffu); Vt[(e0 + 13) * 136 + t] = (bf16)(v1.z >> 16);
      Vt[(e0 + 14) * 136 + t] = (bf16)(v1.w & 0xffffu); Vt[(e0 + 15) * 136 + t] = (bf16)(v1.w >> 16);
    }
    if (MX == 0) {
      const int d = tid & 31, e0 = (tid >> 5) * 4;
      const float4 s4 = *(const float4*)(p.gla_loc() + ((size_t)unit * 32 + d) * 64 + e0);
      St[(e0 + 0) * 72 + d] = f2bf(s4.x); St[(e0 + 1) * 72 + d] = f2bf(s4.y); St[(e0 + 2) * 72 + d] = f2bf(s4.z); St[(e0 + 3) * 72 + d] = f2bf(s4.w);
    } else {
      const int d = tid & 63, e0 = (tid >> 6) * 8;
      const float* sp = ((MX == 1) ? p.ml_c() : p.ret_loc()) + ((size_t)unit * 64 + d) * 64 + e0;
      const float4 s4 = *(const float4*)sp, s5 = *(const float4*)(sp + 4);
      St[(e0 + 0) * 72 + d] = f2bf(s4.x); St[(e0 + 1) * 72 + d] = f2bf(s4.y); St[(e0 + 2) * 72 + d] = f2bf(s4.z); St[(e0 + 3) * 72 + d] = f2bf(s4.w);
      St[(e0 + 4) * 72 + d] = f2bf(s5.x); St[(e0 + 5) * 72 + d] = f2bf(s5.y); St[(e0 + 6) * 72 + d] = f2bf(s5.z); St[(e0 + 7) * 72 + d] = f2bf(s5.w);
    }
    if (MX == 1) {
      mprev = p.ml_mprev()[unit];
      if (tid < 128) {
        const float g = p.ml_g()[TROW(tid) * 4 + h], pm = p.ml_pm()[TROW(tid) * 4 + h], cf = p.ml_cf()[TROW(tid) * 4 + h];
        va[tid] = fmaxf(mprev, pm); vb[tid] = g; vc[tid] = cf;
        Vt[64 * 136 + tid] = (bf16)0x3F80;
#pragma unroll
        for (int i = 65; i < 80; ++i) Vt[i * 136 + tid] = 0;
      }
      if (tid < 64) {
        St[64 * 72 + tid] = f2bf(p.ml_n()[(size_t)unit * 64 + tid]);
#pragma unroll
        for (int i = 65; i < 80; ++i) St[i * 72 + tid] = 0;
      }
    }
  }
  __syncthreads();
  const int ktmax = w | 1;
#pragma unroll
  for (int kt = 0; kt < 8; ++kt) {
    if (kt <= ktmax) {
      f32x4 s = f32x4{0.f, 0.f, 0.f, 0.f};
#pragma unroll
      for (int kb = 0; kb < DK / 32; ++kb) {
        const bf16x8 a = *(const bf16x8*)(Qs + (16 * w + r) * 72 + kb * 32 + q4 * 8);
        const bf16x8 bq = *(const bf16x8*)(Ks + (16 * kt + r) * 72 + kb * 32 + q4 * 8);
        s = MFMA(bq, a, s);
      }
      const int qq = 16 * w + r;
      const float vaq = (MX == 1) ? va[qq] : 0.f;
      float sw[4];
#pragma unroll
      for (int j = 0; j < 4; ++j) {
        const int kk = 16 * kt + 4 * q4 + j;
        float wgt = 0.f;
        if (kk <= qq) {
          if (MX == 0) wgt = 1.f;
          else if (MX == 1) wgt = __expf(vb[kk] - vaq);
          else wgt = exp2f((float)(qq - kk) * l2g);
        }
        sw[j] = s[j] * wgt;
      }
      uint2 so; so.x = pk2(sw[0], sw[1]); so.y = pk2(sw[2], sw[3]);
      *(uint2*)(Ss + qq * 136 + 16 * kt + 4 * q4) = so;
    }
  }
  __syncthreads();
  f32x4 o[NE], o2[NE];
#pragma unroll
  for (int et = 0; et < NE; ++et) { o[et] = f32x4{0.f, 0.f, 0.f, 0.f}; o2[et] = f32x4{0.f, 0.f, 0.f, 0.f}; }
  const int kend = 16 * (ktmax + 1);
  for (int k0 = 0; k0 < kend; k0 += 32) {
    const bf16x8 a = *(const bf16x8*)(Ss + (16 * w + r) * 136 + k0 + q4 * 8);
#pragma unroll
    for (int et = 0; et < NE; ++et) {
      const bf16x8 bv = *(const bf16x8*)(Vt + (16 * et + r) * 136 + k0 + q4 * 8);
      o[et] = MFMA(bv, a, o[et]);
    }
  }
#pragma unroll
  for (int kb = 0; kb < DK / 32; ++kb) {
    const bf16x8 a = *(const bf16x8*)(Qs + (16 * w + r) * 72 + kb * 32 + q4 * 8);
#pragma unroll
    for (int et = 0; et < NE; ++et) {
      const bf16x8 bs = *(const bf16x8*)(St + (16 * et + r) * 72 + kb * 32 + q4 * 8);
      o2[et] = MFMA(bs, a, o2[et]);
    }
  }
  const float* ng = ((MX == 0) ? p.gla_norm : (MX == 1 ? p.ml_norm : p.ret_norm)) + layer * 256 + h * 64 + 4 * q4;
  {
    const int qq = 16 * w + r;
    float rsc = 1.f;
    if (MX == 1) rsc = __expf(mprev - va[qq]);
    if (MX == 2) rsc = exp2f((float)(qq + 1) * l2g);
    f32x4 ov[4];
#pragma unroll
    for (int et = 0; et < 4; ++et) ov[et] = o[et] + o2[et] * rsc;
    if (MX == 1) {
      float den = o[NE - 1][0] + rsc * o2[NE - 1][0];
      den = __shfl(den, r);
      const float fl = __expf(-(vc[qq] + va[qq]));
      const float inv = 1.f / fmaxf(fabsf(den), fl);
#pragma unroll
      for (int et = 0; et < 4; ++et) ov[et] = ov[et] * inv;
    }
    float ss = 0.f;
#pragma unroll
    for (int et = 0; et < 4; ++et) ss += ov[et][0] * ov[et][0] + ov[et][1] * ov[et][1] + ov[et][2] * ov[et][2] + ov[et][3] * ov[et][3];
    ss += __shfl_xor(ss, 16); ss += __shfl_xor(ss, 32);
    const float rms = rsqrtf(ss * (1.f / 64.f) + EPS);
    bf16* yp = p.y() + TROW(qq) * D + (MX + 1) * 256 + h * 64 + 4 * q4;
#pragma unroll
    for (int et = 0; et < 4; ++et) {
      const float4 g4 = *(const float4*)(ng + 16 * et);
      const float t0 = lo16(gpre[et].x), t1 = hi16(gpre[et].x), t2 = lo16(gpre[et].y), t3 = hi16(gpre[et].y);
      const float a0 = (MX == 1) ? sigm(t0) : silu(t0), a1 = (MX == 1) ? sigm(t1) : silu(t1), a2 = (MX == 1) ? sigm(t2) : silu(t2), a3 = (MX == 1) ? sigm(t3) : silu(t3);
      uint2 ov2;
      ov2.x = pk2(ov[et][0] * rms * g4.x * a0, ov[et][1] * rms * g4.y * a1);
      ov2.y = pk2(ov[et][2] * rms * g4.z * a2, ov[et][3] * rms * g4.w * a3);
      *(uint2*)(yp + 16 * et) = ov2;
    }
  }

}

#define XB_TMO      128
#define XB_XCNT(j)  (256  + 64 * (j))
#define XB_XSUB(j)  (1280 + 64 * (j))
#define XB_XGEN(j)  (2304 + 64 * (j))
#define XB_TOP      3328
#define XB_TOPGEN   3392
#define XCD_BAR_WORDS 3456
#define XB_SPIN_CAP (1u << 18)
#define XLAS __attribute__((address_space(3)))

__device__ __forceinline__ unsigned xb_ld(unsigned* p)              { return __hip_atomic_load(p, __ATOMIC_RELAXED, __HIP_MEMORY_SCOPE_AGENT); }
__device__ __forceinline__ unsigned xb_add(unsigned* p, unsigned v) { return __hip_atomic_fetch_add(p, v, __ATOMIC_RELAXED, __HIP_MEMORY_SCOPE_AGENT); }
__device__ __forceinline__ unsigned xb_xcc_id() { return (unsigned)__builtin_amdgcn_s_getreg((3 << 11) | 20) & 0xFu; }
#define XB_SPIN(cond, bar) do { unsigned _sp = 0; while (cond) { __builtin_amdgcn_s_sleep(1); \
    if ((++_sp & 255u) == 0u) { if (xb_ld(&(bar)[XB_TMO])) break; if (_sp > XB_SPIN_CAP) { atomicAdd(&(bar)[XB_TMO], 1u); break; } } } } while (0)

struct XcdBarrier {
    unsigned* bar; unsigned x;
    volatile XLAS unsigned* st;
};

__device__ __forceinline__ XcdBarrier xcd_barrier_post(unsigned* bar, volatile XLAS unsigned* st) {
    XcdBarrier b; b.bar = bar; b.x = xb_xcc_id(); b.st = st;
    if (threadIdx.x == 0) (void)xb_add(&bar[XB_XCNT(b.x)], 1u);
    return b;
}
__device__ __forceinline__ void xcd_barrier_complete(unsigned* bar, unsigned x, unsigned& nloc, unsigned& nx) {
    const unsigned G = gridDim.x * gridDim.y * gridDim.z;
    unsigned sum, cnt, mine, sp = 0u;
    for (;;) {
        sum = 0u; cnt = 0u; mine = 0u;
#pragma unroll
        for (unsigned j = 0; j < 16; ++j) { const unsigned c = xb_ld(&bar[XB_XCNT(j)]); sum += c; cnt += (c > 0u) ? 1u : 0u; mine = (j == x) ? c : mine; }
        if (sum == G) break;
        __builtin_amdgcn_s_sleep(1);
        if ((++sp & 255u) == 0u) { if (xb_ld(&bar[XB_TMO])) break; if (sp > XB_SPIN_CAP) { atomicAdd(&bar[XB_TMO], 1u); break; } }
    }
    nloc = mine > 0u ? mine : 1u; nx = cnt > 0u ? cnt : 1u;
}

__device__ __forceinline__ void xcd_barrier(const XcdBarrier& b) {
    asm volatile("s_waitcnt vmcnt(0)" ::: "memory");
    __syncthreads();
    if (threadIdx.x == 0) {
        unsigned* bar = b.bar;
        __builtin_amdgcn_s_waitcnt(0);
        unsigned nloc = b.st[0], nx = b.st[1];
        if (nloc == 0u) { xcd_barrier_complete(bar, b.x, nloc, nx); b.st[0] = nloc; b.st[1] = nx; }
        const unsigned old = xb_add(&bar[XB_XSUB(b.x)], 1u);
        const unsigned gen = old / nloc;
        if (old + 1u == (gen + 1u) * nloc) {
            __builtin_amdgcn_fence(__ATOMIC_RELEASE, "agent");
            asm volatile("s_waitcnt vmcnt(0)" ::: "memory");
            const unsigned og = xb_add(&bar[XB_TOP], 1u);
            const unsigned tg = og / nx;
            if (og + 1u == (tg + 1u) * nx) xb_add(&bar[XB_TOPGEN], 1u);
            else XB_SPIN(xb_ld(&bar[XB_TOPGEN]) == tg, bar);
            __builtin_amdgcn_fence(__ATOMIC_ACQUIRE, "agent");
            xb_add(&bar[XB_XGEN(b.x)], 1u);
            asm volatile("s_waitcnt vmcnt(0)" ::: "memory");
        } else {
            XB_SPIN(xb_ld(&bar[XB_XGEN(b.x)]) == gen, bar);
            __builtin_amdgcn_fence(__ATOMIC_ACQUIRE, "agent");
            asm volatile("s_waitcnt vmcnt(0)" ::: "memory");
        }
    }
    __syncthreads();
}


__global__ void __launch_bounds__(NT) mega(P p) {
  extern __shared__ __attribute__((aligned(16))) char smem[];
  cg::grid_group grid = cg::this_grid();
  volatile XLAS unsigned* xst = (volatile XLAS unsigned*)(smem + LDS_MAIN);
  if (threadIdx.x == 0) { xst[0] = 0u; xst[1] = 0u; }
  __syncthreads();
  (void)xcd_barrier_post(p.bar(), xst);
#define GRID_BAR() do { XcdBarrier xb_; xb_.bar = p.bar(); xb_.x = xb_xcc_id(); xb_.st = xst; xcd_barrier(xb_); } while (0)
  phase_init_rows(p);
  phase_rope(p);
  phase_cvt(p, -1, 0, smem);
  if (gridDim.y == 12345u) grid.sync();
  GRID_BAR();
  for (int layer = 0; layer < DEPTH; ++layer) {
    { EpiU e; e.O = p.U(); fast_gemm(smem, p.xn(), p.Win_t(), MROWS, NPAD_IN, D, e); }
    GRID_BAR();
    for (int u = blockIdx.x; u < SB_M1 + 3 * NUNIT; u += gridDim.x) {
      if (u < SB_M1) sb_unit(p, u, smem);
      else {
        const int v = u - SB_M1, kind = v / NUNIT, uu = v % NUNIT;
        if (kind == 0) gla_prep_unit(p, layer, uu, smem);
        else if (kind == 1) ml_prep_unit(p, layer, uu, smem);
        else ret_prep_unit(p, layer, uu, smem);
      }
    }
    GRID_BAR();
    phase_scan(p);
    phase_cvt(p, layer, (layer + 1 < DEPTH) ? layer + 1 : -1, smem);
    GRID_BAR();
    for (int u = blockIdx.x; u < 3 * NUNIT + (NUNIT - SB_M1); u += gridDim.x) {
      if (u >= 3 * NUNIT) { sb_unit(p, SB_M1 + (u - 3 * NUNIT), smem); continue; }
      const int kind = u / NUNIT, uu = u % NUNIT;
      if (kind == 0) out_unit<0>(p, layer, uu, smem);
      else if (kind == 1) out_unit<1>(p, layer, uu, smem);
      else out_unit<2>(p, layer, uu, smem);
    }
    GRID_BAR();
    phase_gemm_merge(p, layer, (bf16*)smem);
    { const int bb_ = obid(); if (bb_ < 32) left_merge(p, layer, bb_, smem); }
    GRID_BAR();
    {
      EpiFused<false> e; e.h = p.h(); e.out = p.out; e.xn = p.xn(); e.gpost = p.g_mix_post + layer * D; e.gnext = p.g_ffn_pre + layer * D;
      e.ex1 = p.ex1(); e.ex2 = p.ex2(); e.cnt1 = p.cnt() + (layer * 4 + 0) * 64; e.cnt2 = p.cnt() + (layer * 4 + 1) * 64;
      fast_gemm(smem, p.xn(), p.Wo_t(), LROW0, D, D, e);
    }
    { const int bb_ = obid(); if (bb_ < 32) left_gemm_f32(p.xn(), D, p.Wo_t(), D, bb_, p.tmp(), smem); }
    GRID_BAR();
    phase_norm(p, p.g_mix_post + layer * D, p.g_ffn_pre + layer * D, false, LROW0, RREAL);
    GRID_BAR();
    { EpiGU e; e.O = p.act(); fast_gemm(smem, p.xn(), p.Wgu_t(), MROWS, 2 * FF, D, e); }
    GRID_BAR();
    const bool last = (layer == DEPTH - 1);
    const float* gnx = p.g_mix_pre + (last ? layer : layer + 1) * D;
    if (!last) {
      EpiFused<false> e; e.h = p.h(); e.out = p.out; e.xn = p.xn(); e.gpost = p.g_ffn_post + layer * D; e.gnext = gnx;
      e.ex1 = p.ex1(); e.ex2 = p.ex2(); e.cnt1 = p.cnt() + (layer * 4 + 2) * 64; e.cnt2 = p.cnt() + (layer * 4 + 3) * 64;
      fast_gemm(smem, p.act(), p.Wd_t(), LROW0, D, FF, e);
    } else {
      EpiFused<true> e; e.h = p.h(); e.out = p.out; e.xn = p.xn(); e.gpost = p.g_ffn_post + layer * D; e.gnext = gnx;
      e.ex1 = p.ex1(); e.ex2 = p.ex2(); e.cnt1 = p.cnt() + (layer * 4 + 2) * 64; e.cnt2 = p.cnt() + (layer * 4 + 3) * 64;
      fast_gemm(smem, p.act(), p.Wd_t(), LROW0, D, FF, e);
    }
    { const int bb_ = obid(); if (bb_ < 32) left_gemm_f32(p.act(), FF, p.Wd_t(), FF, bb_, p.tmp(), smem); }
    GRID_BAR();
    phase_norm(p, p.g_ffn_post + layer * D, gnx, last, LROW0, RREAL);
    if (!last) GRID_BAR();
  }
}

extern "C" void kernel_launch(void* const* d_in, const int* in_sizes, int n_in, void* d_out, int out_size, void* d_ws,
                              size_t ws_size, hipStream_t stream) {
  static int grid_blocks = 0;
  if (!grid_blocks) {
    int dev = 0, cus = 0, per_cu = 0;
    hipGetDevice(&dev);
    hipDeviceGetAttribute(&cus, hipDeviceAttributeMultiprocessorCount, dev);
    hipFuncSetAttribute((const void*)mega, hipFuncAttributeMaxDynamicSharedMemorySize, LDS_BYTES);
    hipOccupancyMaxActiveBlocksPerMultiprocessor(&per_cu, (const void*)mega, NT, LDS_BYTES);
    if (per_cu < 1) per_cu = 1;
    grid_blocks = cus * per_cu;
  }
  P p{};
  const float* const* in = (const float* const*)d_in;
  p.x = in[0]; p.meta = in[1]; p.g_mix_pre = in[2]; p.g_mix_post = in[3]; p.g_ffn_pre = in[4]; p.g_ffn_post = in[5];
  p.w_in = in[6]; p.gla_wg = in[7]; p.gla_bg = in[8]; p.gla_norm = in[9]; p.ml_conv = in[10]; p.ml_bi = in[11];
  p.ml_bf = in[12]; p.ml_norm = in[13]; p.ret_norm = in[14]; p.w_branch = in[15]; p.b_merge = in[16]; p.w_out = in[17];
  p.w_gate = in[18]; p.w_up = in[19]; p.w_down = in[20];
  p.out = (float*)d_out;
  p.ws = (char*)d_ws;
  if (WS_TOTAL > ws_size) { fprintf(stderr, "kernel_launch: workspace too small: need %zu have %zu\n", (size_t)WS_TOTAL, ws_size); return; }
  if (hipMemsetAsync(p.ws + OFF_bar, 0, (size_t)(3456 + 1024) * 4, stream) != hipSuccess) { fprintf(stderr, "kernel_launch: memset of barrier words failed\n"); return; }
  void* args[] = {&p};
  hipError_t e = hipLaunchCooperativeKernel((const void*)mega, dim3(grid_blocks), dim3(NT), args, LDS_BYTES, stream);
  if (e != hipSuccess) fprintf(stderr, "cooperative launch failed: %s (grid %d)\n", hipGetErrorString(e), grid_blocks);
}
```

```cpp
#include <hip/hip_runtime.h>
#include <hip/hip_cooperative_groups.h>
#include <cstdio>
#include <cstdint>
namespace cg = cooperative_groups;

typedef unsigned short bf16;
typedef __attribute__((ext_vector_type(8))) short bf16x8;
typedef __attribute__((ext_vector_type(4))) short bf16x4;
typedef __attribute__((ext_vector_type(4))) float f32x4;

constexpr int NT = 512;
constexpr int D = 1024, NB = 2, SEQ = 8192, LT = 8320, MROWS = NB * LT, DEPTH = 4, NCH = 65, US = 7704, FF = 2816;
constexpr int NPAD_IN = 7936;
constexpr int C_SBQ = 0, C_SBK = 256, C_SBV = 512, C_GQ = 768, C_GK = 896, C_GV = 1024, C_GR = 1280, C_GC = 1536,
              C_MQK = 1552, C_MV = 2064, C_MI = 2320, C_MF = 2324, C_MO = 2328, C_RQ = 2584, C_RK = 2840, C_RV = 3096,
              C_RG = 3352, C_MG = 3608;
constexpr int RB = 8208, RREAL = 2 * RB, PADB = 112;
constexpr int LROW0 = 64 * 256;
constexpr int NUNIT = NB * 4 * NCH;
constexpr int SB_M1 = 488;
constexpr int LDS_MAIN = 136192;
constexpr int LDS_BYTES = LDS_MAIN + 64;
constexpr float EPS = 1e-6f;

constexpr size_t al256(size_t x) { return (x + 255) & ~(size_t)255; }
constexpr size_t OFF_h = 0;
constexpr size_t OFF_xn = OFF_h + al256((size_t)MROWS * D * 4);
constexpr size_t OFF_U = OFF_xn + al256((size_t)MROWS * D * 2);
constexpr size_t OFF_y = OFF_U + al256((size_t)MROWS * US * 2);
constexpr size_t OFF_mlqk = OFF_y + al256((size_t)MROWS * D * 2);
constexpr size_t OFF_Win_t = OFF_mlqk + al256((size_t)MROWS * 512 * 2);
constexpr size_t OFF_Wb_t = OFF_Win_t + al256((size_t)NPAD_IN * D * 2);
constexpr size_t OFF_Wo_t = OFF_Wb_t + al256((size_t)4 * 1024 * 256 * 2);
constexpr size_t OFF_Wgu_t = OFF_Wo_t + al256((size_t)1024 * 1024 * 2);
constexpr size_t OFF_Wd_t = OFF_Wgu_t + al256((size_t)2 * FF * D * 2);
constexpr size_t OFF_gla_loc = OFF_Wd_t + al256((size_t)D * FF * 2);
constexpr size_t OFF_gla_dec = OFF_gla_loc + al256((size_t)NUNIT * 2048 * 4);
constexpr size_t OFF_ml_c = OFF_gla_dec + al256((size_t)NUNIT * 32 * 4);
constexpr size_t OFF_ml_n = OFF_ml_c + al256((size_t)NUNIT * 4096 * 4);
constexpr size_t OFF_ml_fl = OFF_ml_n + al256((size_t)NUNIT * 64 * 4);
constexpr size_t OFF_ml_al = OFF_ml_fl + al256((size_t)NUNIT * 4);
constexpr size_t OFF_ml_mprev = OFF_ml_al + al256((size_t)NUNIT * 4);
constexpr size_t OFF_ml_g = OFF_ml_mprev + al256((size_t)NUNIT * 4);
constexpr size_t OFF_ml_pm = OFF_ml_g + al256((size_t)MROWS * 4 * 4);
constexpr size_t OFF_ml_cf = OFF_ml_pm + al256((size_t)MROWS * 4 * 4);
constexpr size_t OFF_ret_loc = OFF_ml_cf + al256((size_t)MROWS * 4 * 4);
constexpr size_t OFF_rope_cos = OFF_ret_loc + al256((size_t)NUNIT * 4096 * 4);
constexpr size_t OFF_rope_sin = OFF_rope_cos + al256((size_t)LT * 32 * 4);
constexpr size_t OFF_tmp = OFF_rope_sin + al256((size_t)LT * 32 * 4);
constexpr size_t OFF_bar = OFF_tmp + al256((size_t)32 * D * 4);
constexpr size_t OFF_ex1 = OFF_bar + al256((size_t)(3456 + 1024) * 4);
constexpr size_t OFF_ex2 = OFF_ex1 + al256((size_t)64 * 4 * 256 * 4);
constexpr size_t WS_TOTAL = OFF_ex2 + al256((size_t)64 * 4 * 256 * 4);
struct P {
  const float *x, *meta, *g_mix_pre, *g_mix_post, *g_ffn_pre, *g_ffn_post, *w_in, *gla_wg, *gla_bg, *gla_norm, *ml_conv,
      *ml_bi, *ml_bf, *ml_norm, *ret_norm, *w_branch, *b_merge, *w_out, *w_gate, *w_up, *w_down;
  float* out;
  char* ws;
  __device__ __forceinline__ bf16* h() const { unsigned o_ = (unsigned)(OFF_h); asm volatile("" : "+s"(o_)); return (bf16*)(ws + o_); }
  __device__ __forceinline__ bf16* xn() const { unsigned o_ = (unsigned)(OFF_xn); asm volatile("" : "+s"(o_)); return (bf16*)(ws + o_); }
  __device__ __forceinline__ bf16* U() const { unsigned o_ = (unsigned)(OFF_U); asm volatile("" : "+s"(o_)); return (bf16*)(ws + o_); }
  __device__ __forceinline__ bf16* y() const { unsigned o_ = (unsigned)(OFF_y); asm volatile("" : "+s"(o_)); return (bf16*)(ws + o_); }
  __device__ __forceinline__ bf16* mlqk() const { unsigned o_ = (unsigned)(OFF_mlqk); asm volatile("" : "+s"(o_)); return (bf16*)(ws + o_); }
  __device__ __forceinline__ bf16* Win_t() const { unsigned o_ = (unsigned)(OFF_Win_t); asm volatile("" : "+s"(o_)); return (bf16*)(ws + o_); }
  __device__ __forceinline__ bf16* Wb_t() const { unsigned o_ = (unsigned)(OFF_Wb_t); asm volatile("" : "+s"(o_)); return (bf16*)(ws + o_); }
  __device__ __forceinline__ bf16* Wo_t() const { unsigned o_ = (unsigned)(OFF_Wo_t); asm volatile("" : "+s"(o_)); return (bf16*)(ws + o_); }
  __device__ __forceinline__ bf16* Wgu_t() const { unsigned o_ = (unsigned)(OFF_Wgu_t); asm volatile("" : "+s"(o_)); return (bf16*)(ws + o_); }
  __device__ __forceinline__ bf16* Wd_t() const { unsigned o_ = (unsigned)(OFF_Wd_t); asm volatile("" : "+s"(o_)); return (bf16*)(ws + o_); }
  __device__ __forceinline__ float* gla_loc() const { unsigned o_ = (unsigned)(OFF_gla_loc); asm volatile("" : "+s"(o_)); return (float*)(ws + o_); }
  __device__ __forceinline__ float* gla_dec() const { unsigned o_ = (unsigned)(OFF_gla_dec); asm volatile("" : "+s"(o_)); return (float*)(ws + o_); }
  __device__ __forceinline__ float* ml_c() const { unsigned o_ = (unsigned)(OFF_ml_c); asm volatile("" : "+s"(o_)); return (float*)(ws + o_); }
  __device__ __forceinline__ float* ml_n() const { unsigned o_ = (unsigned)(OFF_ml_n); asm volatile("" : "+s"(o_)); return (float*)(ws + o_); }
  __device__ __forceinline__ float* ml_fl() const { unsigned o_ = (unsigned)(OFF_ml_fl); asm volatile("" : "+s"(o_)); return (float*)(ws + o_); }
  __device__ __forceinline__ float* ml_al() const { unsigned o_ = (unsigned)(OFF_ml_al); asm volatile("" : "+s"(o_)); return (float*)(ws + o_); }
  __device__ __forceinline__ float* ml_mprev() const { unsigned o_ = (unsigned)(OFF_ml_mprev); asm volatile("" : "+s"(o_)); return (float*)(ws + o_); }
  __device__ __forceinline__ float* ml_g() const { unsigned o_ = (unsigned)(OFF_ml_g); asm volatile("" : "+s"(o_)); return (float*)(ws + o_); }
  __device__ __forceinline__ float* ml_pm() const { unsigned o_ = (unsigned)(OFF_ml_pm); asm volatile("" : "+s"(o_)); return (float*)(ws + o_); }
  __device__ __forceinline__ float* ml_cf() const { unsigned o_ = (unsigned)(OFF_ml_cf); asm volatile("" : "+s"(o_)); return (float*)(ws + o_); }
  __device__ __forceinline__ float* ret_loc() const { unsigned o_ = (unsigned)(OFF_ret_loc); asm volatile("" : "+s"(o_)); return (float*)(ws + o_); }
  __device__ __forceinline__ float* rope_cos() const { unsigned o_ = (unsigned)(OFF_rope_cos); asm volatile("" : "+s"(o_)); return (float*)(ws + o_); }
  __device__ __forceinline__ float* rope_sin() const { unsigned o_ = (unsigned)(OFF_rope_sin); asm volatile("" : "+s"(o_)); return (float*)(ws + o_); }
  __device__ __forceinline__ float* tmp() const { unsigned o_ = (unsigned)(OFF_U + (size_t)100663296); asm volatile("" : "+s"(o_)); return (float*)(ws + o_); }
  __device__ __forceinline__ unsigned* bar() const { unsigned o_ = (unsigned)(OFF_bar); asm volatile("" : "+s"(o_)); return (unsigned*)(ws + o_); }
  __device__ __forceinline__ unsigned* cnt() const { unsigned o_ = (unsigned)(OFF_bar + 3456 * 4); asm volatile("" : "+s"(o_)); return (unsigned*)(ws + o_); }
  __device__ __forceinline__ float* ex1() const { unsigned o_ = (unsigned)(OFF_ex1); asm volatile("" : "+s"(o_)); return (float*)(ws + o_); }
  __device__ __forceinline__ float* ex2() const { unsigned o_ = (unsigned)(OFF_ex2); asm volatile("" : "+s"(o_)); return (float*)(ws + o_); }
  __device__ __forceinline__ bf16* act() const { unsigned o_ = (unsigned)(OFF_U); asm volatile("" : "+s"(o_)); return (bf16*)(ws + o_); }
};

__device__ __forceinline__ size_t rowof(int b, int s) { return (size_t)((s >= PADB) ? b * RB + s - PADB : RREAL + b * PADB + s); }
#define TROW(t) ((size_t)((c == 0 && (t) < PADB) ? rpad + (t) : rbase + (t)))
__device__ __forceinline__ float bf2f(bf16 h) { return __uint_as_float(((unsigned)h) << 16); }
__device__ __forceinline__ unsigned pk2(float a, float b) { unsigned r; asm("v_cvt_pk_bf16_f32 %0, %1, %2" : "=v"(r) : "v"(a), "v"(b)); return r; }
__device__ __forceinline__ bf16 f2bf(float f) { return (bf16)(pk2(f, 0.f) & 0xffffu); }
__device__ __forceinline__ float lo16(unsigned v) { return __uint_as_float(v << 16); }
__device__ __forceinline__ float hi16(unsigned v) { return __uint_as_float(v & 0xffff0000u); }
__device__ __forceinline__ float sigm(float x) { return __builtin_amdgcn_rcpf(1.f + __expf(-x)); }
__device__ __forceinline__ float silu(float x) { return x * sigm(x); }
__device__ __forceinline__ float logsig(float x) { return fminf(x, 0.f) - __logf(1.f + __expf(-fabsf(x))); }
__device__ __forceinline__ float softplus(float x) { return fmaxf(x, 0.f) + __logf(1.f + __expf(-fabsf(x))); }
__device__ __forceinline__ float wave_sum(float v) {
#pragma unroll
  for (int o = 1; o < 64; o <<= 1) v += __shfl_xor(v, o);
  return v;
}
__device__ __forceinline__ float scan_add(float v, int lane) {
#pragma unroll
  for (int o = 1; o < 64; o <<= 1) { float t = __shfl_up(v, o); if (lane >= o) v += t; }
  return v;
}
__device__ __forceinline__ float scan_max(float v, int lane) {
#pragma unroll
  for (int o = 1; o < 64; o <<= 1) { float t = __shfl_up(v, o); if (lane >= o) v = fmaxf(v, t); }
  return v;
}
__device__ __forceinline__ int obid() { int b = blockIdx.x; asm volatile("" : "+s"(b)); return b; }
__device__ __forceinline__ int otid() { int t = threadIdx.x; asm volatile("" : "+v"(t)); return t; }
#define MFMA(a, b, c) __builtin_amdgcn_mfma_f32_16x16x32_bf16((a), (b), (c), 0, 0, 0)

#define UNPK8(v, f) { f[0] = lo16(v.x); f[1] = hi16(v.x); f[2] = lo16(v.y); f[3] = hi16(v.y); f[4] = lo16(v.z); f[5] = hi16(v.z); f[6] = lo16(v.w); f[7] = hi16(v.w); }

__device__ __forceinline__ void write_xn_row(bf16* dst, const float4 (&v)[4], float rs, const float* g, int lane, bool valid) {
#pragma unroll
  for (int i = 0; i < 4; ++i) {
    const int c = i * 256 + lane * 4;
    float4 gg = *(const float4*)(g + c);
    uint2 o;
    if (valid) { o.x = pk2(v[i].x * rs * gg.x, v[i].y * rs * gg.y); o.y = pk2(v[i].z * rs * gg.z, v[i].w * rs * gg.w); }
    else { o.x = 0u; o.y = 0u; }
    *(uint2*)(dst + c) = o;
  }
}

__device__ void phase_init_rows(const P& p) {
  const int tid_ = otid();
  const int lane = tid_ & 63;
  const int gw = blockIdx.x * (NT / 64) + (tid_ >> 6), nw = gridDim.x * (NT / 64);
  for (int row = gw; row < MROWS; row += nw) {
    const float* src = nullptr;
    if (row < RREAL) {
      const int b = row / RB, tt = row % RB + PADB;
      src = (tt >= 128) ? (p.x + ((size_t)b * SEQ + (tt - 128)) * D) : (p.meta + (size_t)(tt - PADB) * D);
    }
    float4 v[4];
    float ss = 0.f;
#pragma unroll
    for (int i = 0; i < 4; ++i) {
      if (src) v[i] = *(const float4*)(src + i * 256 + lane * 4); else v[i] = make_float4(0.f, 0.f, 0.f, 0.f);
      ss += v[i].x * v[i].x + v[i].y * v[i].y + v[i].z * v[i].z + v[i].w * v[i].w;
      { uint2 hb_; hb_.x = pk2(v[i].x, v[i].y); hb_.y = pk2(v[i].z, v[i].w); *(uint2*)(p.h() + (size_t)row * D + i * 256 + lane * 4) = hb_; }
    }
    ss = wave_sum(ss);
    const float rs = rsqrtf(ss * (1.f / D) + EPS);
    write_xn_row(p.xn() + (size_t)row * D, v, rs, p.g_mix_pre, lane, row < RREAL);
  }
}

__device__ void phase_norm(const P& p, const float* gpost, const float* gnext, bool last, int rowbeg, int rowend) {
  const int tid_ = otid();
  const int lane = tid_ & 63;
  const int gw = blockIdx.x * (NT / 64) + (tid_ >> 6), nw = gridDim.x * (NT / 64);
  for (int row = rowbeg + gw; row < rowend; row += nw) {
    const int b = row / RB, t = row % RB + PADB;
    float4 m[4], hv[4];
    float ss = 0.f;
#pragma unroll
    for (int i = 0; i < 4; ++i) {
      m[i] = *(const float4*)(p.tmp() + (size_t)row * D + i * 256 + lane * 4);
      { const uint2 hb_ = *(const uint2*)(p.h() + (size_t)row * D + i * 256 + lane * 4); hv[i] = make_float4(lo16(hb_.x), hi16(hb_.x), lo16(hb_.y), hi16(hb_.y)); }
      ss += m[i].x * m[i].x + m[i].y * m[i].y + m[i].z * m[i].z + m[i].w * m[i].w;
    }
    ss = wave_sum(ss);
    const float rs = rsqrtf(ss * (1.f / D) + EPS);
    float ss2 = 0.f;
#pragma unroll
    for (int i = 0; i < 4; ++i) {
      float4 gg = *(const float4*)(gpost + i * 256 + lane * 4);
      hv[i].x += m[i].x * rs * gg.x; hv[i].y += m[i].y * rs * gg.y; hv[i].z += m[i].z * rs * gg.z; hv[i].w += m[i].w * rs * gg.w;
      ss2 += hv[i].x * hv[i].x + hv[i].y * hv[i].y + hv[i].z * hv[i].z + hv[i].w * hv[i].w;
    }
    if (last) {
      if (t >= 128) {
#pragma unroll
        for (int i = 0; i < 4; ++i) *(float4*)(p.out + ((size_t)b * SEQ + (t - 128)) * D + i * 256 + lane * 4) = hv[i];
      }
    } else {
#pragma unroll
      for (int i = 0; i < 4; ++i) { uint2 hb_; hb_.x = pk2(hv[i].x, hv[i].y); hb_.y = pk2(hv[i].z, hv[i].w); *(uint2*)(p.h() + (size_t)row * D + i * 256 + lane * 4) = hb_; }
      ss2 = wave_sum(ss2);
      const float rs2 = rsqrtf(ss2 * (1.f / D) + EPS);
      write_xn_row(p.xn() + (size_t)row * D, hv, rs2, gnext, lane, true);
    }
  }
}

__device__ void phase_rope(const P& p) {
  const int g = blockIdx.x * NT + otid(), n = gridDim.x * NT;
  for (int idx = g; idx < LT * 32; idx += n) {
    const int s = idx >> 5, i = idx & 31;
    const double invf = exp2(-(double)i * (13.287712379549449 / 32.0));
    const float invf32 = (float)invf;
    const float angf = (float)(s - 112) * invf32;
    double rev = (double)angf * 0.15915494309189535;
    rev -= floor(rev);
    const float rf = (float)rev;
    p.rope_cos()[idx] = __builtin_amdgcn_cosf(rf);
    p.rope_sin()[idx] = __builtin_amdgcn_sinf(rf);
  }
}

__device__ __forceinline__ void cvt_item(const float* W, int K, int N, bf16* Wt, int Npad, int mode, int item, float* scr, int lane) {
  const int nblk = Npad / 32, kb = item / nblk, nb = item % nblk, k0 = 64 * kb, n0 = 32 * nb;
  const int nn = n0 + (lane & 31);
  const bool ok = nn < N;
  {
    const float* wp = W + (size_t)(k0 + (lane >> 5)) * N + (ok ? nn : 0);
    const size_t step = (size_t)2 * N;
    float v[32];
#pragma unroll
    for (int i = 0; i < 32; ++i) { v[i] = *wp; wp += step; }
#pragma unroll
    for (int i = 0; i < 32; ++i) scr[(2 * i + (lane >> 5)) * 33 + (lane & 31)] = ok ? v[i] : 0.f;
  }
  asm volatile("s_waitcnt lgkmcnt(0)" ::: "memory");
  const int c = lane & 7;
#pragma unroll
  for (int j = 0; j < 4; ++j) {
    const int n = (lane >> 3) + 8 * j;
    const float* sp = scr + (8 * c) * 33 + n;
    uint4 o;
    o.x = pk2(sp[0 * 33], sp[1 * 33]); o.y = pk2(sp[2 * 33], sp[3 * 33]); o.z = pk2(sp[4 * 33], sp[5 * 33]); o.w = pk2(sp[6 * 33], sp[7 * 33]);
    const int rn = n0 + n;
    int dst = rn;
    if (mode == 1) dst = (rn >> 7) * 256 + (rn & 127);
    if (mode == 2) dst = (rn >> 7) * 256 + 128 + (rn & 127);
    *(uint4*)(Wt + (size_t)dst * K + k0 + 8 * c) = o;
  }
  asm volatile("s_waitcnt lgkmcnt(0)" ::: "memory");
}

constexpr int CU_IN = 16 * (NPAD_IN / 32);
constexpr int CU_WB = 4 * 4 * 32;
constexpr int CU_WO = 16 * 32;
constexpr int CU_WG = 16 * 88;
constexpr int CU_WD = 44 * 32;
constexpr int CU_LATE = CU_WB + CU_WO + 2 * CU_WG + CU_WD;

__device__ void cvt_late(const P& p, int layer, int u, float* scr, int lane) {
  if (u < CU_WB) { const int br = u / 128, uu = u % 128;
    cvt_item(p.w_branch + ((size_t)layer * 4 + br) * 256 * 1024, 256, 1024, p.Wb_t() + (size_t)br * 1024 * 256, 1024, 0, uu, scr, lane); return; }
  u -= CU_WB;
  if (u < CU_WO) { cvt_item(p.w_out + (size_t)layer * 1024 * 1024, 1024, 1024, p.Wo_t(), 1024, 0, u, scr, lane); return; }
  u -= CU_WO;
  if (u < CU_WG) { cvt_item(p.w_gate + (size_t)layer * 1024 * FF, 1024, FF, p.Wgu_t(), FF, 1, u, scr, lane); return; }
  u -= CU_WG;
  if (u < CU_WG) { cvt_item(p.w_up + (size_t)layer * 1024 * FF, 1024, FF, p.Wgu_t(), FF, 2, u, scr, lane); return; }
  u -= CU_WG;
  cvt_item(p.w_down + (size_t)layer * FF * 1024, FF, 1024, p.Wd_t(), 1024, 0, u, scr, lane);
}
__device__ void cvt_in(const P& p, int layer, int u, float* scr, int lane) {
  cvt_item(p.w_in + (size_t)layer * 1024 * US, 1024, US, p.Win_t(), NPAD_IN, 0, u, scr, lane);
}
__device__ void phase_cvt(const P& p, int late_layer, int in_layer, char* smem) {
  const int tid = otid(), lane = tid & 63, w = tid >> 6;
  float* scr = (float*)smem + w * (64 * 33);
  const int gw = blockIdx.x * (NT / 64) + w, nw = gridDim.x * (NT / 64);
  __syncthreads();
  if (late_layer >= 0) for (int u = gw; u < CU_LATE; u += nw) cvt_late(p, late_layer, u, scr, lane);
  if (in_layer >= 0) for (int u = gw; u < CU_IN; u += nw) cvt_in(p, in_layer, u, scr, lane);
  __syncthreads();
}

__device__ __forceinline__ void gemm_mainloop(const bf16* __restrict__ A, int lda, const bf16* __restrict__ Bt, int ldb, int K,
                                              int row0, int col0, f32x4 (&acc)[4][4], bf16* lds) {
  const int tid = otid(), lane = tid & 63, w = tid >> 6, wm = w >> 1, wn = w & 1, r = lane & 15, q = lane >> 4;
  bf16* As = lds;
  bf16* Bs = lds + 2 * 256 * 72;
  const int lr = tid >> 3, lc = (tid & 7) * 8;
  const bf16* ga = A + (size_t)(row0 + lr) * lda + lc;
  const bf16* gb = Bt + (size_t)(col0 + lr) * ldb + lc;
  uint4 ra[4], rb[2];
  const int nk = K / 64;
#pragma unroll
  for (int i = 0; i < 4; ++i) ra[i] = *(const uint4*)(ga + (size_t)(64 * i) * lda);
#pragma unroll
  for (int i = 0; i < 2; ++i) rb[i] = *(const uint4*)(gb + (size_t)(64 * i) * ldb);
#pragma unroll
  for (int i = 0; i < 4; ++i) *(uint4*)(As + (lr + 64 * i) * 72 + lc) = ra[i];
#pragma unroll
  for (int i = 0; i < 2; ++i) *(uint4*)(Bs + (lr + 64 * i) * 72 + lc) = rb[i];
  __syncthreads();
  for (int kt = 0; kt < nk; ++kt) {
    const int cur = kt & 1;
    const bool more = (kt + 1 < nk);
    if (more) {
#pragma unroll
      for (int i = 0; i < 4; ++i) ra[i] = *(const uint4*)(ga + (size_t)(64 * i) * lda + (kt + 1) * 64);
#pragma unroll
      for (int i = 0; i < 2; ++i) rb[i] = *(const uint4*)(gb + (size_t)(64 * i) * ldb + (kt + 1) * 64);
    }
    const bf16* as = As + cur * 256 * 72 + (wm * 64 + r) * 72 + q * 8;
    const bf16* bs = Bs + cur * 128 * 72 + (wn * 64 + r) * 72 + q * 8;
#pragma unroll
    for (int ks = 0; ks < 2; ++ks) {
      bf16x8 af[4], bfr[4];
#pragma unroll
      for (int mt = 0; mt < 4; ++mt) af[mt] = *(const bf16x8*)(as + mt * 16 * 72 + ks * 32);
#pragma unroll
      for (int nt = 0; nt < 4; ++nt) bfr[nt] = *(const bf16x8*)(bs + nt * 16 * 72 + ks * 32);
#pragma unroll
      for (int nt = 0; nt < 4; ++nt)
#pragma unroll
        for (int mt = 0; mt < 4; ++mt) acc[nt][mt] = MFMA(bfr[nt], af[mt], acc[nt][mt]);
    }
    if (more) {
      const int nx = cur ^ 1;
#pragma unroll
      for (int i = 0; i < 4; ++i) *(uint4*)(As + nx * 256 * 72 + (lr + 64 * i) * 72 + lc) = ra[i];
#pragma unroll
      for (int i = 0; i < 2; ++i) *(uint4*)(Bs + nx * 128 * 72 + (lr + 64 * i) * 72 + lc) = rb[i];
    }
    __syncthreads();
  }
}

__device__ __forceinline__ void tile_coords(int id, int ntn, int& tm, int& tn, int NTM = MROWS / 256) {
  constexpr int GM = 16;
  const int per = GM * ntn;
  const int g = id / per, rem = id % per;
  const int gsz = (NTM - g * GM) < GM ? (NTM - g * GM) : GM;
  tm = g * GM + rem % gsz;
  tn = rem / gsz;
}

#define ZERO_ACC(acc) { _Pragma("unroll") for (int a_ = 0; a_ < 4; ++a_) _Pragma("unroll") for (int b_ = 0; b_ < 4; ++b_) acc[a_][b_] = f32x4{0.f, 0.f, 0.f, 0.f}; }

__device__ void phase_gemm_u(const P& p, bf16* lds) {
  constexpr int NTN = NPAD_IN / 128;
  const int tid_ = otid();
  const int lane = tid_ & 63, w = tid_ >> 6, wm = w >> 1, wn = w & 1, r = lane & 15, q = lane >> 4;
  for (int id = blockIdx.x; id < 65 * NTN; id += gridDim.x) {
    int tm, tn; tile_coords(id, NTN, tm, tn);
    const int row0 = tm * 256, col0 = tn * 128;
    f32x4 acc[4][4]; ZERO_ACC(acc);
    gemm_mainloop(p.xn(), D, p.Win_t(), D, D, row0, col0, acc, lds);
#pragma unroll
    for (int nt = 0; nt < 4; ++nt) {
      const int n = col0 + wn * 64 + nt * 16 + 4 * q;
      if (n < US) {
#pragma unroll
        for (int mt = 0; mt < 4; ++mt) {
          const int m = row0 + wm * 64 + mt * 16 + r;
          uint2 o; o.x = pk2(acc[nt][mt][0], acc[nt][mt][1]); o.y = pk2(acc[nt][mt][2], acc[nt][mt][3]);
          *(uint2*)(p.U() + (size_t)m * US + n) = o;
        }
      }
    }
  }
}

__device__ void phase_gemm_merge(const P& p, int layer, bf16* lds) {
  constexpr int NTN = 8, NTM = LROW0 / 128, LDT = 264;
  const int tid = otid();
  const int lane = tid & 63, w = tid >> 6, wm = w >> 1, wn = w & 1, r = lane & 15, q = lane >> 4;
  bf16* As = lds;
  bf16* Bs = lds + 128 * LDT;
  const int lrow = tid >> 5, lcol = (tid & 31) * 8;
  const int pbase = 16 * ((lrow >> 2) & 1) + 4 * (lrow >> 3) + (lrow & 3);
  const int ntile = (NTM * NTN - (int)blockIdx.x + (int)gridDim.x - 1) / (int)gridDim.x;
  const int nit = ntile * 4;
  if (nit <= 0) return;
  uint4 ra0, ra1, ra2, ra3, ra4, ra5, ra6, ra7, rb0, rb1, rb2, rb3, rb4, rb5, rb6, rb7;
  {
    int tm, tn; tile_coords(blockIdx.x, NTN, tm, tn, NTM);
    const bf16* ga = p.y() + (size_t)(tm * 128 + lrow) * D + lcol;
    const bf16* gb = p.Wb_t() + (size_t)(tn * 128 + lrow) * 256 + lcol;
    ra0 = *(const uint4*)(ga + (size_t)(16 * 0) * D); ra1 = *(const uint4*)(ga + (size_t)(16 * 1) * D); ra2 = *(const uint4*)(ga + (size_t)(16 * 2) * D); ra3 = *(const uint4*)(ga + (size_t)(16 * 3) * D); ra4 = *(const uint4*)(ga + (size_t)(16 * 4) * D); ra5 = *(const uint4*)(ga + (size_t)(16 * 5) * D); ra6 = *(const uint4*)(ga + (size_t)(16 * 6) * D); ra7 = *(const uint4*)(ga + (size_t)(16 * 7) * D);
    rb0 = *(const uint4*)(gb + (size_t)(16 * 0) * 256); rb1 = *(const uint4*)(gb + (size_t)(16 * 1) * 256); rb2 = *(const uint4*)(gb + (size_t)(16 * 2) * 256); rb3 = *(const uint4*)(gb + (size_t)(16 * 3) * 256); rb4 = *(const uint4*)(gb + (size_t)(16 * 4) * 256); rb5 = *(const uint4*)(gb + (size_t)(16 * 5) * 256); rb6 = *(const uint4*)(gb + (size_t)(16 * 6) * 256); rb7 = *(const uint4*)(gb + (size_t)(16 * 7) * 256);
  }
  __syncthreads();
  *(uint4*)(As + (lrow + 16 * 0) * LDT + lcol) = ra0; *(uint4*)(As + (lrow + 16 * 1) * LDT + lcol) = ra1; *(uint4*)(As + (lrow + 16 * 2) * LDT + lcol) = ra2; *(uint4*)(As + (lrow + 16 * 3) * LDT + lcol) = ra3; *(uint4*)(As + (lrow + 16 * 4) * LDT + lcol) = ra4; *(uint4*)(As + (lrow + 16 * 5) * LDT + lcol) = ra5; *(uint4*)(As + (lrow + 16 * 6) * LDT + lcol) = ra6; *(uint4*)(As + (lrow + 16 * 7) * LDT + lcol) = ra7;
  *(uint4*)(Bs + (pbase + 0) * LDT + lcol) = rb0; *(uint4*)(Bs + (pbase + 8) * LDT + lcol) = rb1; *(uint4*)(Bs + (pbase + 32) * LDT + lcol) = rb2; *(uint4*)(Bs + (pbase + 40) * LDT + lcol) = rb3; *(uint4*)(Bs + (pbase + 64) * LDT + lcol) = rb4; *(uint4*)(Bs + (pbase + 72) * LDT + lcol) = rb5; *(uint4*)(Bs + (pbase + 96) * LDT + lcol) = rb6; *(uint4*)(Bs + (pbase + 104) * LDT + lcol) = rb7;
  __syncthreads();
  f32x4 macc[4][2], acc[4][2];
  for (int it = 0; it < nit; ++it) {
    const int br = it & 3;
    int tm, tn; tile_coords(blockIdx.x + (it >> 2) * gridDim.x, NTN, tm, tn, NTM);
    const int row0 = tm * 128, col0 = tn * 128;
#pragma unroll
    for (int a_ = 0; a_ < 4; ++a_)
#pragma unroll
      for (int b_ = 0; b_ < 2; ++b_) { acc[a_][b_] = f32x4{0.f, 0.f, 0.f, 0.f}; if (br == 0) macc[a_][b_] = f32x4{0.f, 0.f, 0.f, 0.f}; }
    const bf16* gU = p.U() + (size_t)(row0 + wm * 32 + r) * US + C_MG + br * 1024 + col0 + wn * 64 + 8 * q;
    uint4 greg[2][2];
#pragma unroll
    for (int pr = 0; pr < 2; ++pr)
#pragma unroll
      for (int mt = 0; mt < 2; ++mt) greg[pr][mt] = *(const uint4*)(gU + (size_t)(mt * 16) * US + pr * 32);
    const bool more = it + 1 < nit;
    if (more) {
      const int itn = it + 1, brn = itn & 3;
      int tmn, tnn; tile_coords(blockIdx.x + (itn >> 2) * gridDim.x, NTN, tmn, tnn, NTM);
      const bf16* ga = p.y() + (size_t)(tmn * 128 + lrow) * D + brn * 256 + lcol;
      const bf16* gb = p.Wb_t() + (size_t)brn * 1024 * 256 + (size_t)(tnn * 128 + lrow) * 256 + lcol;
      ra0 = *(const uint4*)(ga + (size_t)(16 * 0) * D); ra1 = *(const uint4*)(ga + (size_t)(16 * 1) * D); ra2 = *(const uint4*)(ga + (size_t)(16 * 2) * D); ra3 = *(const uint4*)(ga + (size_t)(16 * 3) * D); ra4 = *(const uint4*)(ga + (size_t)(16 * 4) * D); ra5 = *(const uint4*)(ga + (size_t)(16 * 5) * D); ra6 = *(const uint4*)(ga + (size_t)(16 * 6) * D); ra7 = *(const uint4*)(ga + (size_t)(16 * 7) * D);
      rb0 = *(const uint4*)(gb + (size_t)(16 * 0) * 256); rb1 = *(const uint4*)(gb + (size_t)(16 * 1) * 256); rb2 = *(const uint4*)(gb + (size_t)(16 * 2) * 256); rb3 = *(const uint4*)(gb + (size_t)(16 * 3) * 256); rb4 = *(const uint4*)(gb + (size_t)(16 * 4) * 256); rb5 = *(const uint4*)(gb + (size_t)(16 * 5) * 256); rb6 = *(const uint4*)(gb + (size_t)(16 * 6) * 256); rb7 = *(const uint4*)(gb + (size_t)(16 * 7) * 256);
    }
    const bf16* as = As + (wm * 32 + r) * LDT + q * 8;
    const bf16* bs = Bs + (wn * 64 + r) * LDT + q * 8;
    {
      bf16x8 af[2][2], bfr[2][4];
#pragma unroll
      for (int mt = 0; mt < 2; ++mt) af[0][mt] = *(const bf16x8*)(as + mt * 16 * LDT);
#pragma unroll
      for (int nt = 0; nt < 4; ++nt) bfr[0][nt] = *(const bf16x8*)(bs + nt * 16 * LDT);
#pragma unroll
      for (int ks = 0; ks < 8; ++ks) {
        const int cb = ks & 1, nb = cb ^ 1;
        if (ks < 7) {
#pragma unroll
          for (int mt = 0; mt < 2; ++mt) af[nb][mt] = *(const bf16x8*)(as + mt * 16 * LDT + (ks + 1) * 32);
#pragma unroll
          for (int nt = 0; nt < 4; ++nt) bfr[nb][nt] = *(const bf16x8*)(bs + nt * 16 * LDT + (ks + 1) * 32);
        }
        __builtin_amdgcn_sched_barrier(0);
#pragma unroll
        for (int nt = 0; nt < 4; ++nt)
#pragma unroll
          for (int mt = 0; mt < 2; ++mt) acc[nt][mt] = MFMA(bfr[cb][nt], af[cb][mt], acc[nt][mt]);
        __builtin_amdgcn_sched_barrier(0);
      }
    }
    __syncthreads();
    if (more) {
      *(uint4*)(As + (lrow + 16 * 0) * LDT + lcol) = ra0; *(uint4*)(As + (lrow + 16 * 1) * LDT + lcol) = ra1; *(uint4*)(As + (lrow + 16 * 2) * LDT + lcol) = ra2; *(uint4*)(As + (lrow + 16 * 3) * LDT + lcol) = ra3; *(uint4*)(As + (lrow + 16 * 4) * LDT + lcol) = ra4; *(uint4*)(As + (lrow + 16 * 5) * LDT + lcol) = ra5; *(uint4*)(As + (lrow + 16 * 6) * LDT + lcol) = ra6; *(uint4*)(As + (lrow + 16 * 7) * LDT + lcol) = ra7;
      *(uint4*)(Bs + (pbase + 0) * LDT + lcol) = rb0; *(uint4*)(Bs + (pbase + 8) * LDT + lcol) = rb1; *(uint4*)(Bs + (pbase + 32) * LDT + lcol) = rb2; *(uint4*)(Bs + (pbase + 40) * LDT + lcol) = rb3; *(uint4*)(Bs + (pbase + 64) * LDT + lcol) = rb4; *(uint4*)(Bs + (pbase + 72) * LDT + lcol) = rb5; *(uint4*)(Bs + (pbase + 96) * LDT + lcol) = rb6; *(uint4*)(Bs + (pbase + 104) * LDT + lcol) = rb7;
    }
    __syncthreads();
#pragma unroll
    for (int nt = 0; nt < 4; ++nt) {
      const int n = col0 + wn * 64 + (nt >> 1) * 32 + 8 * q + 4 * (nt & 1);
      const float4 bm = *(const float4*)(p.b_merge + ((size_t)layer * 4 + br) * 1024 + n);
#pragma unroll
      for (int mt = 0; mt < 2; ++mt) {
        const uint4 lg4 = greg[nt >> 1][mt];
        const unsigned gx = (nt & 1) ? lg4.z : lg4.x, gy = (nt & 1) ? lg4.w : lg4.y;
        macc[nt][mt][0] += sigm(lo16(gx) + bm.x) * acc[nt][mt][0];
        macc[nt][mt][1] += sigm(hi16(gx) + bm.y) * acc[nt][mt][1];
        macc[nt][mt][2] += sigm(lo16(gy) + bm.z) * acc[nt][mt][2];
        macc[nt][mt][3] += sigm(hi16(gy) + bm.w) * acc[nt][mt][3];
      }
    }
    if (br == 3) {
#pragma unroll
      for (int pr = 0; pr < 2; ++pr) {
        const int n = col0 + wn * 64 + pr * 32 + 8 * q;
#pragma unroll
        for (int mt = 0; mt < 2; ++mt) {
          const int m = row0 + wm * 32 + mt * 16 + r;
          uint4 o;
          o.x = pk2(macc[2 * pr][mt][0], macc[2 * pr][mt][1]); o.y = pk2(macc[2 * pr][mt][2], macc[2 * pr][mt][3]);
          o.z = pk2(macc[2 * pr + 1][mt][0], macc[2 * pr + 1][mt][1]); o.w = pk2(macc[2 * pr + 1][mt][2], macc[2 * pr + 1][mt][3]);
          *(uint4*)(p.xn() + (size_t)m * D + n) = o;
        }
      }
    }
  }
}

__device__ void phase_gemm_f32(const P& p, const bf16* A, int lda, const bf16* Wt, int K, bf16* lds) {
  constexpr int NTN = 8;
  const int tid_ = otid();
  const int lane = tid_ & 63, w = tid_ >> 6, wm = w >> 1, wn = w & 1, r = lane & 15, q = lane >> 4;
  for (int id = blockIdx.x; id < 65 * NTN; id += gridDim.x) {
    int tm, tn; tile_coords(id, NTN, tm, tn);
    const int row0 = tm * 256, col0 = tn * 128;
    f32x4 acc[4][4]; ZERO_ACC(acc);
    gemm_mainloop(A, lda, Wt, K, K, row0, col0, acc, lds);
#pragma unroll
    for (int nt = 0; nt < 4; ++nt) {
      const int n = col0 + wn * 64 + nt * 16 + 4 * q;
#pragma unroll
      for (int mt = 0; mt < 4; ++mt) {
        const int m = row0 + wm * 64 + mt * 16 + r;
        *(float4*)(p.tmp() + (size_t)m * D + n) = make_float4(acc[nt][mt][0], acc[nt][mt][1], acc[nt][mt][2], acc[nt][mt][3]);
      }
    }
  }
}

__device__ void phase_gemm_gu(const P& p, bf16* lds) {
  constexpr int NTN = 2 * FF / 128;
  const int tid_ = otid();
  const int lane = tid_ & 63, w = tid_ >> 6, wm = w >> 1, wn = w & 1, r = lane & 15, q = lane >> 4;
  for (int id = blockIdx.x; id < 65 * NTN; id += gridDim.x) {
    int tm, tn; tile_coords(id, NTN, tm, tn);
    const int row0 = tm * 256, col0 = tn * 128;
    f32x4 acc[4][4]; ZERO_ACC(acc);
    gemm_mainloop(p.xn(), D, p.Wgu_t(), D, D, row0, col0, acc, lds);
#pragma unroll
    for (int pr = 0; pr < 2; ++pr) {
      const int ac = (col0 + wn * 64 + pr * 32) / 2 + 4 * q;
#pragma unroll
      for (int mt = 0; mt < 4; ++mt) {
        const int m = row0 + wm * 64 + mt * 16 + r;
        float v0 = silu(acc[2 * pr][mt][0]) * acc[2 * pr + 1][mt][0];
        float v1 = silu(acc[2 * pr][mt][1]) * acc[2 * pr + 1][mt][1];
        float v2 = silu(acc[2 * pr][mt][2]) * acc[2 * pr + 1][mt][2];
        float v3 = silu(acc[2 * pr][mt][3]) * acc[2 * pr + 1][mt][3];
        uint2 o; o.x = pk2(v0, v1); o.y = pk2(v2, v3);
        *(uint2*)(p.act() + (size_t)m * FF + ac) = o;
      }
    }
  }
}

namespace pg8 {
#define PG8_LAS __attribute__((address_space(3)))
typedef unsigned short bf16_t;
typedef short bf16x8 __attribute__((ext_vector_type(8)));
typedef float f32x4 __attribute__((ext_vector_type(4)));
typedef unsigned u32x4 __attribute__((ext_vector_type(4)));
constexpr int BM = 256, BK = 64, HALF = 128, HTB = HALF * BK * 2  , STAGE_BYTES = 8 * HTB, NXCD = 8, WGM = 8;

__host__ __device__ __forceinline__ int lds_byte(int r, int c) { const int st = (r >> 4) * 2 + (c >> 5), rr = r & 15, cc = c & 31, ob = rr * 64 + cc * 2; return st * 1024 + (ob ^ (((ob >> 9) & 1) << 5)); }
__host__ __device__ __forceinline__ void stage_rc(int b, int& R, int& C) { const int st = b / 1024, sb = b % 1024, swz = sb ^ (((sb >> 9) & 1) << 5); R = (st >> 1) * 16 + swz / 64; C = (st & 1) * 32 + (swz % 64) / 2; }
__host__ __device__ __forceinline__ int perm32(int rho) { const int n = rho >> 4, i = rho & 15; return 8 * (i >> 2) + 4 * n + (i & 3); }

struct Unit { int pm, pn; };
struct Gemm { const bf16_t* A; const bf16_t* Bt; int M, N, K; };

struct StaticOrder {
    int nM, nN, nwg, G, c;
    __host__ __device__ void init(int M, int N, int G_, int c_) { nM = M / BM; nN = N / BM; nwg = nM * nN; G = G_; c = c_; }
    __host__ __device__ bool next(int i, Unit& u) const {
        const long L = (long)i * G + c; if (L >= nwg) return false;
        int wgid = (int)L; { const int q = nwg / NXCD, r = nwg % NXCD, xcd = wgid % NXCD, off = wgid / NXCD; wgid = (xcd < r ? xcd * (q + 1) : r * (q + 1) + (xcd - r) * q) + off; }
        const int nig = WGM * nN, gid = wgid / nig, fm = gid * WGM, gsz = (nM - fm) < WGM ? (nM - fm) : WGM;
        u.pm = fm + ((wgid % nig) % gsz); u.pn = (wgid % nig) / gsz; return true;
    }
    __device__ __forceinline__ void a_ready(const Unit&) const {}
    __device__ __forceinline__ void done(const Unit&) const {}
};

template <class Epi, class Sched>
__device__ __forceinline__ void gemm_phase(PG8_LAS unsigned char* lds, const Gemm g, const Sched& S, const Epi& E) {
    const int tid = otid(), wid = __builtin_amdgcn_readfirstlane(tid >> 6), lane = tid & 63, wr = wid >> 2, wc = wid & 3, fr = lane & 15, fq = lane >> 4;
    const int K = g.K, nt = K / BK;
    unsigned voffA[2], voffB[2];
#pragma unroll
    for (int i = 0; i < 2; ++i) { int R, C; stage_rc(tid * 16 + i * 8192, R, C); const int Rb = Epi::PERM ? ((R & ~31) + perm32(R & 31)) : R;
        voffA[i] = (unsigned)(R * K + C) * 2u; voffB[i] = (unsigned)(Rb * K + C) * 2u; }
    const size_t kstep = (size_t)(BK * 2);
    const size_t hstep = (size_t)HALF * K * 2;
    const size_t tstep = 2 * hstep;
    const unsigned ldsw = (unsigned)wid * 1024u;
    const int aoff = lds_byte(wr * 64 + fr, fq * 8), boff = lds_byte(wc * 32 + fr, fq * 8);
#define PG8_SA(b, h) (((b) * 2 + (h)) * HTB)
#define PG8_SB(b, h) ((4 + (b) * 2 + (h)) * HTB)
#define PG8_STAGE(bufoff, gbase, voff) do { _Pragma("unroll") for (int _i = 0; _i < 2; ++_i) \
        __builtin_amdgcn_global_load_lds((const unsigned*)((const char*)(gbase) + (voff)[_i]), (PG8_LAS unsigned*)(lds + (bufoff) + ldsw + _i * 8192), 16, 0, 0); } while (0)
#define PG8_LDA(dst, b, h) do { _Pragma("unroll") for (int m = 0; m < 4; ++m) _Pragma("unroll") for (int k = 0; k < 2; ++k) dst[m][k] = *(const PG8_LAS bf16x8*)(lds + PG8_SA(b, h) + aoff + m * 2048 + k * 1024); } while (0)
#define PG8_LDB(dst, b, h) do { _Pragma("unroll") for (int n = 0; n < 2; ++n) _Pragma("unroll") for (int k = 0; k < 2; ++k) dst[n][k] = *(const PG8_LAS bf16x8*)(lds + PG8_SB(b, h) + boff + n * 2048 + k * 1024); } while (0)
#define PG8_MMA(ai, bj, At, Bt) do { __builtin_amdgcn_s_setprio(1); _Pragma("unroll") for (int m = 0; m < 4; ++m) _Pragma("unroll") for (int n = 0; n < 2; ++n) _Pragma("unroll") for (int k = 0; k < 2; ++k) \
        acc[ai][bj][m][n] = __builtin_amdgcn_mfma_f32_16x16x32_bf16(Bt[n][k], At[m][k], acc[ai][bj][m][n], 0, 0, 0); __builtin_amdgcn_s_setprio(0); } while (0)
#define PG8_WAIT_V(n) asm volatile("s_waitcnt vmcnt(" #n ")" ::: "memory")
#define PG8_WAIT_L(n) asm volatile("s_waitcnt lgkmcnt(" #n ")" ::: "memory")
#define PG8_BAR __builtin_amdgcn_s_barrier()
#define PG8_SCHED __builtin_amdgcn_sched_barrier(0)
    Unit cur, nxt; int ui = 0;
    if (!S.next(0, cur)) return;
    f32x4 acc[2][2][4][2];
#pragma unroll
    for (int a = 0; a < 2; ++a)
#pragma unroll
        for (int b = 0; b < 2; ++b)
#pragma unroll
            for (int m = 0; m < 4; ++m)
#pragma unroll
                for (int n = 0; n < 2; ++n) acc[a][b][m][n] = (f32x4){0.f, 0.f, 0.f, 0.f};
    bf16x8 At[4][2], B0[2][2], B1[2][2];
    const char* cA = (const char*)g.A + (size_t)cur.pm * tstep; const char* cB = (const char*)g.Bt + (size_t)cur.pn * tstep;
    S.a_ready(cur);
    PG8_STAGE(PG8_SB(0, 0), cB, voffB); PG8_STAGE(PG8_SA(0, 0), cA, voffA); PG8_STAGE(PG8_SB(0, 1), cB + hstep, voffB); PG8_STAGE(PG8_SA(0, 1), cA + hstep, voffA);
    if (wr == 1) PG8_BAR;
    PG8_WAIT_V(4); PG8_BAR;
    PG8_STAGE(PG8_SB(1, 0), cB + kstep, voffB); PG8_STAGE(PG8_SA(1, 0), cA + kstep, voffA); PG8_STAGE(PG8_SB(1, 1), cB + hstep + kstep, voffB);
    PG8_WAIT_V(6); PG8_BAR;
    for (;;) {
        const bool has_next = S.next(ui + 1, nxt);
        const char* nA = has_next ? (const char*)g.A + (size_t)nxt.pm * tstep : cA; const char* nB = has_next ? (const char*)g.Bt + (size_t)nxt.pn * tstep : cB;
        for (int t = 0; t < nt; t += 2) {
            const bool last = (t == nt - 2);
            const char* a1 = cA + (size_t)(t + 1) * kstep;
            const char* a2 = last ? nA : cA + (size_t)(t + 2) * kstep; const char* b2 = last ? nB : cB + (size_t)(t + 2) * kstep;
            const char* a3 = a2 + kstep; const char* b3 = b2 + kstep;
            if (last && has_next) S.a_ready(nxt);
            PG8_LDB(B0, 0, 0); PG8_SCHED; PG8_LDA(At, 0, 0); PG8_STAGE(PG8_SA(1, 1), a1 + hstep, voffA);
            PG8_WAIT_L(8); PG8_BAR; PG8_WAIT_L(0); PG8_MMA(0, 0, At, B0); PG8_BAR; PG8_SCHED;
            PG8_LDB(B1, 0, 1); PG8_STAGE(PG8_SB(0, 0), b2, voffB);
            PG8_BAR; PG8_WAIT_L(0); PG8_MMA(0, 1, At, B1); PG8_BAR;
            PG8_LDA(At, 0, 1); PG8_STAGE(PG8_SA(0, 0), a2, voffA);
            PG8_BAR; PG8_WAIT_L(0); PG8_MMA(1, 0, At, B0); PG8_BAR; PG8_SCHED;
            PG8_STAGE(PG8_SB(0, 1), b2 + hstep, voffB);
            PG8_WAIT_V(6); PG8_BAR; PG8_MMA(1, 1, At, B1); PG8_BAR;
            PG8_LDB(B0, 1, 0); PG8_SCHED; PG8_LDA(At, 1, 0); PG8_STAGE(PG8_SA(0, 1), a2 + hstep, voffA);
            PG8_WAIT_L(8); PG8_BAR; PG8_WAIT_L(0); PG8_MMA(0, 0, At, B0); PG8_BAR; PG8_SCHED;
            PG8_LDB(B1, 1, 1); PG8_STAGE(PG8_SB(1, 0), b3, voffB);
            PG8_BAR; PG8_WAIT_L(0); PG8_MMA(0, 1, At, B1); PG8_BAR;
            PG8_LDA(At, 1, 1); PG8_STAGE(PG8_SA(1, 0), a3, voffA);
            PG8_BAR; PG8_WAIT_L(0); PG8_MMA(1, 0, At, B0); PG8_BAR; PG8_SCHED;
            PG8_STAGE(PG8_SB(1, 1), b3 + hstep, voffB);
            PG8_WAIT_V(6); PG8_BAR; PG8_MMA(1, 1, At, B1); PG8_BAR;
        }
        if constexpr (!Epi::AFTER_DRAIN) { E(acc, cur, wr, wc, fr, fq); S.done(cur); }
        if (!has_next) break;
#pragma unroll
        for (int a = 0; a < 2; ++a)
#pragma unroll
            for (int b = 0; b < 2; ++b)
#pragma unroll
                for (int m = 0; m < 4; ++m)
#pragma unroll
                    for (int n = 0; n < 2; ++n) acc[a][b][m][n] = (f32x4){0.f, 0.f, 0.f, 0.f};
        cur = nxt; cA = nA; cB = nB; ++ui;
    }
    PG8_WAIT_V(0);
    if (wr == 0) PG8_BAR;
    PG8_BAR;
    if constexpr (Epi::AFTER_DRAIN) { E.fused(acc, cur, wr, wc, fr, fq, lds, wid, lane); S.done(cur); }
#undef PG8_SA
#undef PG8_SB
#undef PG8_STAGE
#undef PG8_LDA
#undef PG8_LDB
#undef PG8_MMA
#undef PG8_WAIT_V
#undef PG8_WAIT_L
#undef PG8_BAR
#undef PG8_SCHED
}
}

struct EpiU {
  static constexpr bool PERM = true, AFTER_DRAIN = false;
  bf16* O;
  __device__ __forceinline__ void operator()(const f32x4 (&acc)[2][2][4][2], const pg8::Unit& u, int wr, int wc, int fr, int fq) const {
    const int row0 = u.pm * 256 + wr * 64 + fr, col0 = u.pn * 256 + wc * 32 + 8 * fq;
#pragma unroll
    for (int ai = 0; ai < 2; ++ai)
#pragma unroll
      for (int m = 0; m < 4; ++m) {
        bf16* rowp = O + (size_t)(row0 + ai * 128 + m * 16) * US + col0;
#pragma unroll
        for (int bj = 0; bj < 2; ++bj) {
          if (col0 + bj * 128 < US) {
            uint4 o;
            o.x = pk2(acc[ai][bj][m][0][0], acc[ai][bj][m][0][1]); o.y = pk2(acc[ai][bj][m][0][2], acc[ai][bj][m][0][3]);
            o.z = pk2(acc[ai][bj][m][1][0], acc[ai][bj][m][1][1]); o.w = pk2(acc[ai][bj][m][1][2], acc[ai][bj][m][1][3]);
            *(uint4*)(rowp + bj * 128) = o;
          }
        }
      }
  }
};
struct EpiF32 {
  static constexpr bool PERM = false, AFTER_DRAIN = false;
  float* C;
  __device__ __forceinline__ void operator()(const f32x4 (&acc)[2][2][4][2], const pg8::Unit& u, int wr, int wc, int fr, int fq) const {
    const int row0 = u.pm * 256 + wr * 64 + fr, col0 = u.pn * 256 + wc * 32 + 4 * fq;
#pragma unroll
    for (int ai = 0; ai < 2; ++ai)
#pragma unroll
      for (int m = 0; m < 4; ++m) {
        float* rowp = C + (size_t)(row0 + ai * 128 + m * 16) * D + col0;
#pragma unroll
        for (int bj = 0; bj < 2; ++bj)
#pragma unroll
          for (int n = 0; n < 2; ++n) *(f32x4*)(rowp + bj * 128 + n * 16) = acc[ai][bj][m][n];
      }
  }
};
struct EpiGU {
  static constexpr bool PERM = true, AFTER_DRAIN = false;
  bf16* O;
  __device__ __forceinline__ void operator()(const f32x4 (&acc)[2][2][4][2], const pg8::Unit& u, int wr, int wc, int fr, int fq) const {
    const int row0 = u.pm * 256 + wr * 64 + fr, col0 = u.pn * 128 + wc * 32 + 8 * fq;
#pragma unroll
    for (int ai = 0; ai < 2; ++ai)
#pragma unroll
      for (int m = 0; m < 4; ++m) {
        bf16* rowp = O + (size_t)(row0 + ai * 128 + m * 16) * FF + col0;
        const f32x4 g0 = acc[ai][0][m][0], g1 = acc[ai][0][m][1], u0 = acc[ai][1][m][0], u1 = acc[ai][1][m][1];
        uint4 o;
        o.x = pk2(silu(g0[0]) * u0[0], silu(g0[1]) * u0[1]); o.y = pk2(silu(g0[2]) * u0[2], silu(g0[3]) * u0[3]);
        o.z = pk2(silu(g1[0]) * u1[0], silu(g1[1]) * u1[1]); o.w = pk2(silu(g1[2]) * u1[2], silu(g1[3]) * u1[3]);
        *(uint4*)rowp = o;
      }
  }
};
template <class Epi>
__device__ __forceinline__ void fast_gemm(char* smem, const bf16* A, const bf16* Bt, int M, int N, int K, const Epi& E) {
  pg8::Gemm g; g.A = A; g.Bt = Bt; g.M = M; g.N = N; g.K = K;
  pg8::StaticOrder S; S.init(M, N, (int)gridDim.x, obid());
  pg8::gemm_phase<Epi, pg8::StaticOrder>((PG8_LAS unsigned char*)smem, g, S, E);
}


__device__ __forceinline__ float ld_sc1(const float* q) { return __hip_atomic_load(q, __ATOMIC_RELAXED, __HIP_MEMORY_SCOPE_AGENT); }
template <bool LAST>
struct EpiFused {
  static constexpr bool PERM = true, AFTER_DRAIN = true;
  bf16* h; float* out; bf16* xn; const float* gpost; const float* gnext; float* ex1; float* ex2; unsigned* cnt1; unsigned* cnt2;
  __device__ __forceinline__ void operator()(const f32x4 (&)[2][2][4][2], const pg8::Unit&, int, int, int, int) const {}
  __device__ __forceinline__ void exchange(const f32x4 (&acc)[2][2][4][2], const pg8::Unit& u, int wr, int wc, int fr, int fq, PG8_LAS float* ssq,
                                           PG8_LAS float* rsv, int tid, float* ex, unsigned* cnt) const {
#pragma unroll
    for (int ai = 0; ai < 2; ++ai)
#pragma unroll
      for (int m = 0; m < 4; ++m) {
        float sv = 0.f;
#pragma unroll
        for (int bj = 0; bj < 2; ++bj)
#pragma unroll
          for (int n = 0; n < 2; ++n) {
            const f32x4 a = acc[ai][bj][m][n];
            sv += a[0] * a[0] + a[1] * a[1] + a[2] * a[2] + a[3] * a[3];
          }
        sv += __shfl_xor(sv, 16); sv += __shfl_xor(sv, 32);
        if (fq == 0) ssq[wc * 256 + ai * 128 + wr * 64 + m * 16 + fr] = sv;
      }
    __syncthreads();
    if (tid < 256) {
      const float t = ssq[tid] + ssq[256 + tid] + ssq[512 + tid] + ssq[768 + tid];
      __hip_atomic_store(ex + (size_t)(u.pm * 4 + u.pn) * 256 + tid, t, __ATOMIC_RELAXED, __HIP_MEMORY_SCOPE_AGENT);
    }
    asm volatile("s_waitcnt vmcnt(0)" ::: "memory");
    __syncthreads();
    if (tid == 0) {
      __builtin_amdgcn_fence(__ATOMIC_RELEASE, "agent");
      asm volatile("s_waitcnt vmcnt(0)" ::: "memory");
      __hip_atomic_fetch_add(cnt + u.pm, 1u, __ATOMIC_RELAXED, __HIP_MEMORY_SCOPE_AGENT);
      unsigned sp = 0;
      while (__hip_atomic_load(cnt + u.pm, __ATOMIC_RELAXED, __HIP_MEMORY_SCOPE_AGENT) < 4u) { __builtin_amdgcn_s_sleep(1); if (++sp > (1u << 22)) break; }
      __builtin_amdgcn_fence(__ATOMIC_ACQUIRE, "agent");
      asm volatile("s_waitcnt vmcnt(0)" ::: "memory");
    }
    __syncthreads();
    if (tid < 256) {
      const float* e = ex + (size_t)(u.pm * 4) * 256 + tid;
      const float t = ld_sc1(e) + ld_sc1(e + 256) + ld_sc1(e + 512) + ld_sc1(e + 768);
      rsv[tid] = rsqrtf(t * (1.f / D) + EPS);
    }
    __syncthreads();
  }
  __device__ __forceinline__ void fused(f32x4 (&acc)[2][2][4][2], const pg8::Unit& u, int wr, int wc, int fr, int fq, PG8_LAS unsigned char* lds, int wid,
                                        int lane) const {
    PG8_LAS float* ssq = (PG8_LAS float*)lds;
    PG8_LAS float* rsv = ssq + 1024;
    const int tid = wid * 64 + lane;
    exchange(acc, u, wr, wc, fr, fq, ssq, rsv, tid, ex1, cnt1);
    const int colb = u.pn * 256 + wc * 32 + 8 * fq;
#pragma unroll
    for (int bj = 0; bj < 2; ++bj) {
      const int c = colb + bj * 128;
      const f32x4 gp0 = *(const f32x4*)(gpost + c), gp1 = *(const f32x4*)(gpost + c + 4);
#pragma unroll
      for (int ai = 0; ai < 2; ++ai)
#pragma unroll
        for (int m = 0; m < 4; ++m) {
          const int rl = ai * 128 + wr * 64 + m * 16 + fr;
          int r = u.pm * 256 + rl;
          asm volatile("" : "+v"(r));
          const float rs = rsv[rl];
          const uint4 hb_ = *(const uint4*)(h + (size_t)r * D + c);
          const f32x4 hv0 = f32x4{lo16(hb_.x), hi16(hb_.x), lo16(hb_.y), hi16(hb_.y)};
          const f32x4 hv1 = f32x4{lo16(hb_.z), hi16(hb_.z), lo16(hb_.w), hi16(hb_.w)};
          const f32x4 nv0 = hv0 + acc[ai][bj][m][0] * rs * gp0;
          const f32x4 nv1 = hv1 + acc[ai][bj][m][1] * rs * gp1;
          acc[ai][bj][m][0] = nv0; acc[ai][bj][m][1] = nv1;
          if (!LAST) {
            uint4 ho_; ho_.x = pk2(nv0[0], nv0[1]); ho_.y = pk2(nv0[2], nv0[3]); ho_.z = pk2(nv1[0], nv1[1]); ho_.w = pk2(nv1[2], nv1[3]);
            *(uint4*)(h + (size_t)r * D + c) = ho_;
          } else {
            const int b = r / RB, tt = r % RB + PADB;
            if (tt >= 128) {
              float* op = out + ((size_t)b * SEQ + (tt - 128)) * D + c;
              *(f32x4*)op = nv0; *(f32x4*)(op + 4) = nv1;
            }
          }
        }
    }
    if (LAST) return;
    __syncthreads();
    exchange(acc, u, wr, wc, fr, fq, ssq, rsv, tid, ex2, cnt2);
#pragma unroll
    for (int bj = 0; bj < 2; ++bj) {
      const int c = colb + bj * 128;
      const f32x4 gn0 = *(const f32x4*)(gnext + c), gn1 = *(const f32x4*)(gnext + c + 4);
#pragma unroll
      for (int ai = 0; ai < 2; ++ai)
#pragma unroll
        for (int m = 0; m < 4; ++m) {
          const int rl = ai * 128 + wr * 64 + m * 16 + fr;
          int r = u.pm * 256 + rl;
          asm volatile("" : "+v"(r));
          const float rs = rsv[rl];
          const f32x4 v0 = acc[ai][bj][m][0] * rs * gn0, v1 = acc[ai][bj][m][1] * rs * gn1;
          uint4 o; o.x = pk2(v0[0], v0[1]); o.y = pk2(v0[2], v0[3]); o.z = pk2(v1[0], v1[1]); o.w = pk2(v1[2], v1[3]);
          *(uint4*)(xn + (size_t)r * D + c) = o;
        }
    }
  }
};

__device__ void left_gemm_f32(const bf16* A, int lda, const bf16* Bt, int K, int cb, float* outp, char* smem) {
  const int tid = otid(), lane = tid & 63, w = tid >> 6, r = lane & 15, q4 = lane >> 4;
  float* red = (float*)smem;
  f32x4 acc[2][2];
#pragma unroll
  for (int i = 0; i < 2; ++i)
#pragma unroll
    for (int j = 0; j < 2; ++j) acc[i][j] = f32x4{0.f, 0.f, 0.f, 0.f};
  const int kc = K / 8, kbeg = w * kc;
  const bf16* ap = A + (size_t)(LROW0 + r) * lda + kbeg + q4 * 8;
  const bf16* bp = Bt + (size_t)(cb * 32 + r) * K + kbeg + q4 * 8;
  __syncthreads();
  for (int k = 0; k < kc; k += 32) {
    bf16x8 a[2], bb[2];
#pragma unroll
    for (int i = 0; i < 2; ++i) { a[i] = *(const bf16x8*)(ap + (size_t)(16 * i) * lda + k); bb[i] = *(const bf16x8*)(bp + (size_t)(16 * i) * K + k); }
#pragma unroll
    for (int i = 0; i < 2; ++i)
#pragma unroll
      for (int j = 0; j < 2; ++j) acc[i][j] = MFMA(a[i], bb[j], acc[i][j]);
  }
#pragma unroll
  for (int i = 0; i < 2; ++i)
#pragma unroll
    for (int j = 0; j < 2; ++j)
#pragma unroll
      for (int jj = 0; jj < 4; ++jj) red[w * 1024 + (16 * i + 4 * q4 + jj) * 32 + 16 * j + r] = acc[i][j][jj];
  __syncthreads();
#pragma unroll
  for (int e = 0; e < 2; ++e) {
    const int idx = tid + e * NT, row = idx >> 5, col = idx & 31;
    float t = 0.f;
#pragma unroll
    for (int ww = 0; ww < 8; ++ww) t += red[ww * 1024 + idx];
    outp[(size_t)(LROW0 + row) * D + cb * 32 + col] = t;
  }
}
__device__ void left_merge(const P& p, int layer, int cb, char* smem) {
  const int tid = otid(), lane = tid & 63, w = tid >> 6, r = lane & 15, q4 = lane >> 4;
  float* red = (float*)smem;
  f32x4 acc[2][2];
#pragma unroll
  for (int i = 0; i < 2; ++i)
#pragma unroll
    for (int j = 0; j < 2; ++j) acc[i][j] = f32x4{0.f, 0.f, 0.f, 0.f};
  const int br = w >> 1, kh = (w & 1) * 128;
  const bf16* ap = p.y() + (size_t)(LROW0 + r) * D + br * 256 + kh + q4 * 8;
  const bf16* bp = p.Wb_t() + (size_t)br * 1024 * 256 + (size_t)(cb * 32 + r) * 256 + kh + q4 * 8;
  __syncthreads();
#pragma unroll
  for (int k = 0; k < 128; k += 32) {
    bf16x8 a[2], bb[2];
#pragma unroll
    for (int i = 0; i < 2; ++i) { a[i] = *(const bf16x8*)(ap + (size_t)(16 * i) * D + k); bb[i] = *(const bf16x8*)(bp + (size_t)(16 * i) * 256 + k); }
#pragma unroll
    for (int i = 0; i < 2; ++i)
#pragma unroll
      for (int j = 0; j < 2; ++j) acc[i][j] = MFMA(a[i], bb[j], acc[i][j]);
  }
#pragma unroll
  for (int i = 0; i < 2; ++i)
#pragma unroll
    for (int j = 0; j < 2; ++j)
#pragma unroll
      for (int jj = 0; jj < 4; ++jj) red[w * 1024 + (16 * i + 4 * q4 + jj) * 32 + 16 * j + r] = acc[i][j][jj];
  __syncthreads();
#pragma unroll
  for (int e = 0; e < 2; ++e) {
    const int idx = tid + e * NT, row = idx >> 5, col = cb * 32 + (idx & 31);
    const size_t prow = (size_t)(LROW0 + row);
    float t = 0.f;
#pragma unroll
    for (int b4 = 0; b4 < 4; ++b4) {
      const float z = red[(2 * b4) * 1024 + idx] + red[(2 * b4 + 1) * 1024 + idx];
      const float lg = bf2f(p.U()[prow * US + C_MG + b4 * 1024 + col]) + p.b_merge[((size_t)layer * 4 + b4) * 1024 + col];
      t += sigm(lg) * z;
    }
    p.xn()[prow * D + col] = f2bf(t);
  }
}

__device__ void sb_unit(const P& p, int unit, char* smem) {
  const int tid = otid(), lane = tid & 63, w = tid >> 6, r = lane & 15, q4 = lane >> 4;
  const int qb = unit % NCH, bh = unit / NCH, h = bh & 3, b = bh >> 2;
  bf16* Ks = (bf16*)smem;
  bf16* Vt = Ks + 64 * 72;
  const int sq = qb * 128 + 16 * w + r;
  bf16x8 qf[2];
  {
    const bf16* qp = p.U() + rowof(b, sq) * US + C_SBQ + h * 64 + q4 * 8;
    qf[0] = *(const bf16x8*)qp;
    qf[1] = *(const bf16x8*)(qp + 32);
  }
  f32x4 o[4];
#pragma unroll
  for (int i = 0; i < 4; ++i) o[i] = f32x4{0.f, 0.f, 0.f, 0.f};
  float R = 0.f;
  const int keyk = tid >> 3, ck = (tid & 7) * 8, key = tid & 63, c0 = (tid >> 6) * 8;
  uint4 kv = *(const uint4*)(p.U() + rowof(b, (2 * qb + 1) * 64 + keyk) * US + C_SBK + h * 64 + ck);
  uint4 vv = *(const uint4*)(p.U() + rowof(b, (2 * qb + 1) * 64 + key) * US + C_SBV + h * 64 + c0);
  for (int jt = 2 * qb + 1; jt >= 1; --jt) {
    __syncthreads();
    {
      *(uint4*)(Ks + keyk * 72 + ck) = kv;
      Vt[(c0 + 0) * 72 + key] = (bf16)(vv.x & 0xffffu); Vt[(c0 + 1) * 72 + key] = (bf16)(vv.x >> 16);
      Vt[(c0 + 2) * 72 + key] = (bf16)(vv.y & 0xffffu); Vt[(c0 + 3) * 72 + key] = (bf16)(vv.y >> 16);
      Vt[(c0 + 4) * 72 + key] = (bf16)(vv.z & 0xffffu); Vt[(c0 + 5) * 72 + key] = (bf16)(vv.z >> 16);
      Vt[(c0 + 6) * 72 + key] = (bf16)(vv.w & 0xffffu); Vt[(c0 + 7) * 72 + key] = (bf16)(vv.w >> 16);
      if (jt > 1) {
        kv = *(const uint4*)(p.U() + rowof(b, (jt - 1) * 64 + keyk) * US + C_SBK + h * 64 + ck);
        vv = *(const uint4*)(p.U() + rowof(b, (jt - 1) * 64 + key) * US + C_SBV + h * 64 + c0);
      }
    }
    asm volatile("s_waitcnt lgkmcnt(0)" ::: "memory");
    __builtin_amdgcn_s_barrier();
    asm volatile("" ::: "memory");
    f32x4 s[4];
#pragma unroll
    for (int mt = 0; mt < 4; ++mt) {
      s[mt] = f32x4{0.f, 0.f, 0.f, 0.f};
#pragma unroll
      for (int kb = 0; kb < 2; ++kb) {
        const bf16x8 a = *(const bf16x8*)(Ks + (16 * mt + r) * 72 + kb * 32 + q4 * 8);
        s[mt] = MFMA(a, qf[kb], s[mt]);
      }
    }
    float T[4];
    f32x4 cs[4];
#pragma unroll
    for (int mt = 0; mt < 4; ++mt) {
      float sp[4];
#pragma unroll
      for (int j = 0; j < 4; ++j) {
        const int sk = jt * 64 + 16 * mt + 4 * q4 + j;
        const bool ok = (sk < sq) && (sk >= 112);
        const float z = s[mt][j] * 0.125f;
        s[mt][j] = ok ? z : -1e30f;
        sp[j] = ok ? softplus(z) : 0.f;
      }
      const float c3 = sp[3], c2 = sp[2] + c3, c1 = sp[1] + c2, c0 = sp[0] + c1;
      const float p1 = __shfl_xor(c0, 16);
      const float pair = c0 + p1;
      const float p2 = __shfl_xor(pair, 32);
      const float above = ((q4 & 1) == 0 ? p1 : 0.f) + ((q4 & 2) == 0 ? p2 : 0.f);
      T[mt] = pair + p2;
      cs[mt][0] = c0 + above; cs[mt][1] = c1 + above; cs[mt][2] = c2 + above; cs[mt][3] = c3 + above;
    }
    float offs[4];
    offs[3] = R; offs[2] = offs[3] + T[3]; offs[1] = offs[2] + T[2]; offs[0] = offs[1] + T[1];
    R = offs[0] + T[0];
    f32x4 a[4];
#pragma unroll
    for (int mt = 0; mt < 4; ++mt)
#pragma unroll
      for (int j = 0; j < 4; ++j) a[mt][j] = __expf(s[mt][j] - (cs[mt][j] + offs[mt]));
#pragma unroll
    for (int kb2 = 0; kb2 < 2; ++kb2) {
      union { bf16x8 v; unsigned u[4]; } pb;
      pb.u[0] = pk2(a[2 * kb2][0], a[2 * kb2][1]); pb.u[1] = pk2(a[2 * kb2][2], a[2 * kb2][3]);
      pb.u[2] = pk2(a[2 * kb2 + 1][0], a[2 * kb2 + 1][1]); pb.u[3] = pk2(a[2 * kb2 + 1][2], a[2 * kb2 + 1][3]);
#pragma unroll
      for (int et = 0; et < 4; ++et) {
        const bf16* vp = Vt + (16 * et + r) * 72 + 32 * kb2 + 4 * q4;
        union { bf16x8 v; uint2 u[2]; } va;
        va.u[0] = *(const uint2*)vp;
        va.u[1] = *(const uint2*)(vp + 16);
        o[et] = MFMA(va.v, pb.v, o[et]);
      }
    }
    if (__syncthreads_and(R > 64.f)) break;
  }
  bf16* yp = p.y() + rowof(b, sq) * D + 0 * 256 + h * 64 + 4 * q4;
#pragma unroll
  for (int et = 0; et < 4; ++et) {
    uint2 ov; ov.x = pk2(o[et][0], o[et][1]); ov.y = pk2(o[et][2], o[et][3]);
    *(uint2*)(yp + 16 * et) = ov;
  }
}

template <int DK, int NE>
__device__ __forceinline__ void local_mfma(const bf16* KxT, const bf16* VxT, float* outc, float* outn) {
  const int tid = otid(), lane = tid & 63, w = tid >> 6, r = lane & 15, q = lane >> 4;
  constexpr int NT_ = (DK / 16) * NE;
#pragma unroll
  for (int ti = 0; ti < (NT_ + 7) / 8; ++ti) {
    const int tl = w + 8 * ti;
    if (tl < NT_) {
      const int dt = tl / NE, et = tl % NE;
      f32x4 acc = f32x4{0.f, 0.f, 0.f, 0.f};
#pragma unroll
      for (int k0 = 0; k0 < 128; k0 += 32) {
        const bf16x8 a = *(const bf16x8*)(KxT + (16 * dt + r) * 136 + k0 + q * 8);
        const bf16x8 bv = *(const bf16x8*)(VxT + (16 * et + r) * 136 + k0 + q * 8);
        acc = MFMA(a, bv, acc);
      }
      if (et < 4) {
#pragma unroll
        for (int j = 0; j < 4; ++j) outc[(16 * dt + 4 * q + j) * 64 + 16 * et + r] = acc[j];
      } else if (r == 0) {
#pragma unroll
        for (int j = 0; j < 4; ++j) outn[16 * dt + 4 * q + j] = acc[j];
      }
    }
  }
}

__device__ __forceinline__ void load_vxT(const bf16* vsrc, bf16* VxT, int c, int rbase, int rpad) {
  const int tid = otid(), e0 = (tid >> 7) * 16, t = tid & 127;
  const bf16* vs = vsrc + TROW(t) * US + e0;
  const uint4 v0 = *(const uint4*)vs, v1 = *(const uint4*)(vs + 8);
  VxT[(e0 + 0) * 136 + t] = (bf16)(v0.x & 0xffffu); VxT[(e0 + 1) * 136 + t] = (bf16)(v0.x >> 16);
  VxT[(e0 + 2) * 136 + t] = (bf16)(v0.y & 0xffffu); VxT[(e0 + 3) * 136 + t] = (bf16)(v0.y >> 16);
  VxT[(e0 + 4) * 136 + t] = (bf16)(v0.z & 0xffffu); VxT[(e0 + 5) * 136 + t] = (bf16)(v0.z >> 16);
  VxT[(e0 + 6) * 136 + t] = (bf16)(v0.w & 0xffffu); VxT[(e0 + 7) * 136 + t] = (bf16)(v0.w >> 16);
  VxT[(e0 + 8) * 136 + t] = (bf16)(v1.x & 0xffffu); VxT[(e0 + 9) * 136 + t] = (bf16)(v1.x >> 16);
  VxT[(e0 + 10) * 136 + t] = (bf16)(v1.y & 0xffffu); VxT[(e0 + 11) * 136 + t] = (bf16)(v1.y >> 16);
  VxT[(e0 + 12) * 136 + t] = (bf16)(v1.z & 0xffffu); VxT[(e0 + 13) * 136 + t] = (bf16)(v1.z >> 16);
  VxT[(e0 + 14) * 136 + t] = (bf16)(v1.w & 0xffffu); VxT[(e0 + 15) * 136 + t] = (bf16)(v1.w >> 16);
}

__device__ void gla_prep_unit(const P& p, int layer, int unit, char* smem) {
  const int tid = otid(), lane = tid & 63, w = tid >> 6;
  const int c = unit % NCH, bh = unit / NCH, h = bh & 3, b = bh >> 2;
  float* la = (float*)smem;
  float* cl = la + 128 * 33;
  bf16* KxT = (bf16*)(cl + 32);
  bf16* VxT = KxT + 32 * 136;
  const int rbase = b * RB + c * 128 - PADB, rpad = RREAL + b * PADB;
  uint4 qv_pre, kv_pre;
  {
    const int t = tid >> 2, d0 = (tid & 3) * 8;
    qv_pre = *(const uint4*)(p.U() + TROW(t) * US + C_GQ + h * 32 + d0);
    kv_pre = *(const uint4*)(p.U() + TROW(t) * US + C_GK + h * 32 + d0);
  }
  __syncthreads();
  {
    const int t = tid >> 2, d0 = (tid & 3) * 8;
    const bf16* cp = p.U() + TROW(t) * US + C_GC;
    const uint4 c0 = *(const uint4*)cp, c1 = *(const uint4*)(cp + 8);
    float cv[16];
    { float f[8]; UNPK8(c0, f);
#pragma unroll
      for (int i = 0; i < 8; ++i) cv[i] = f[i];
      UNPK8(c1, f);
#pragma unroll
      for (int i = 0; i < 8; ++i) cv[8 + i] = f[i]; }
    const float* wg = p.gla_wg + (size_t)layer * 16 * 128 + h * 32 + d0;
    float acc[8];
    {
      const float4 b0 = *(const float4*)(p.gla_bg + layer * 128 + h * 32 + d0), b1 = *(const float4*)(p.gla_bg + layer * 128 + h * 32 + d0 + 4);
      acc[0] = b0.x; acc[1] = b0.y; acc[2] = b0.z; acc[3] = b0.w; acc[4] = b1.x; acc[5] = b1.y; acc[6] = b1.z; acc[7] = b1.w;
    }
#pragma unroll
    for (int rr = 0; rr < 16; ++rr) {
      const float4 w0 = *(const float4*)(wg + rr * 128), w1 = *(const float4*)(wg + rr * 128 + 4);
      acc[0] += cv[rr] * w0.x; acc[1] += cv[rr] * w0.y; acc[2] += cv[rr] * w0.z; acc[3] += cv[rr] * w0.w;
      acc[4] += cv[rr] * w1.x; acc[5] += cv[rr] * w1.y; acc[6] += cv[rr] * w1.z; acc[7] += cv[rr] * w1.w;
    }
#pragma unroll
    for (int i = 0; i < 8; ++i) la[t * 33 + d0 + i] = logsig(acc[i]) * (1.f / 16.f);
  }
  __syncthreads();
#pragma unroll
  for (int i = 0; i < 4; ++i) {
    const int d = 4 * w + i;
    const float v0 = la[(2 * lane) * 33 + d], v1 = la[(2 * lane + 1) * 33 + d];
    const float s = v0 + v1;
    const float incl = scan_add(s, lane);
    la[(2 * lane) * 33 + d] = incl - s + v0;
    la[(2 * lane + 1) * 33 + d] = incl;
    if (lane == 63) cl[d] = incl;
  }
  __syncthreads();
  {
    const int t = tid >> 2, d0 = (tid & 3) * 8;
    bf16* qp = p.U() + TROW(t) * US + C_GQ + h * 32 + d0;
    bf16* kp = p.U() + TROW(t) * US + C_GK + h * 32 + d0;
    const uint4 qv = qv_pre, kv = kv_pre;
    float qf[8], kf[8], qd[8], kd[8], kx8[8];
    UNPK8(qv, qf); UNPK8(kv, kf);
#pragma unroll
    for (int i = 0; i < 8; ++i) {
      const float cum = la[t * 33 + d0 + i];
      qd[i] = qf[i] * 0.17677669529663687f * __expf(cum);
      kd[i] = kf[i] * __expf(-cum);
      kx8[i] = kf[i] * __expf(cl[d0 + i] - cum);
    }
#pragma unroll
    for (int i = 0; i < 8; ++i) KxT[(d0 + i) * 136 + t] = f2bf(kx8[i]);
    uint4 qo, ko;
    qo.x = pk2(qd[0], qd[1]); qo.y = pk2(qd[2], qd[3]); qo.z = pk2(qd[4], qd[5]); qo.w = pk2(qd[6], qd[7]);
    ko.x = pk2(kd[0], kd[1]); ko.y = pk2(kd[2], kd[3]); ko.z = pk2(kd[4], kd[5]); ko.w = pk2(kd[6], kd[7]);
    *(uint4*)qp = qo; *(uint4*)kp = ko;
    load_vxT(p.U() + C_GV + h * 64, VxT, c, rbase, rpad);
  }
  __syncthreads();
  local_mfma<32, 4>(KxT, VxT, p.gla_loc() + (size_t)unit * 2048, nullptr);
  if (tid < 32) p.gla_dec()[unit * 32 + tid] = __expf(cl[tid]);
}

__device__ void ml_prep_unit(const P& p, int layer, int unit, char* smem) {
  const int tid = otid(), lane = tid & 63, w = tid >> 6;
  const int c = unit % NCH, bh = unit / NCH, h = bh & 3, b = bh >> 2;
  bf16* KxT = (bf16*)smem;
  bf16* VxT = KxT + 64 * 136;
  float* pe = (float*)(VxT + 80 * 136);
  const int rbase = b * RB + c * 128 - PADB, rpad = RREAL + b * PADB;
  uint4 cx[4][4];
  {
    const int t = tid >> 2, d0 = (tid & 3) * 16;
    const int sidx = c * 128 + t;
#pragma unroll
    for (int j = 0; j < 4; ++j) {
      const int ts = sidx - 3 + j;
      const bf16* xp = p.U() + rowof(b, ts >= 0 ? ts : 0) * US + C_MQK + h * 64 + d0;
      cx[j][0] = *(const uint4*)xp; cx[j][1] = *(const uint4*)(xp + 8); cx[j][2] = *(const uint4*)(xp + 256); cx[j][3] = *(const uint4*)(xp + 264);
    }
  }
  __syncthreads();
  if (w == 0) {
    const int t0 = 2 * lane, t1 = t0 + 1;
    const float bi = p.ml_bi[layer * 4 + h], bff = p.ml_bf[layer * 4 + h];
    const float li0 = bf2f(p.U()[TROW(t0) * US + C_MI + h]) + bi, li1 = bf2f(p.U()[TROW(t1) * US + C_MI + h]) + bi;
    const float lf0 = logsig(bf2f(p.U()[TROW(t0) * US + C_MF + h]) + bff), lf1 = logsig(bf2f(p.U()[TROW(t1) * US + C_MF + h]) + bff);
    const float s = lf0 + lf1;
    const float incl = scan_add(s, lane);
    const float cf0 = incl - s + lf0, cf1 = incl;
    const float cum_last = __shfl(incl, 63);
    const float g0 = li0 - cf0, g1 = li1 - cf1;
    const float mx = fmaxf(g0, g1);
    const float inclm = scan_max(mx, lane);
    float exm = __shfl_up(inclm, 1);
    if (lane == 0) exm = -3.0e38f;
    const float pm0 = fmaxf(exm, g0), pm1 = inclm;
    const float gmax = __shfl(inclm, 63);
    pe[t0] = __expf(g0 - gmax); pe[t1] = __expf(g1 - gmax);
    p.ml_g()[TROW(t0) * 4 + h] = g0; p.ml_g()[TROW(t1) * 4 + h] = g1;
    p.ml_pm()[TROW(t0) * 4 + h] = pm0; p.ml_pm()[TROW(t1) * 4 + h] = pm1;
    p.ml_cf()[TROW(t0) * 4 + h] = cf0; p.ml_cf()[TROW(t1) * 4 + h] = cf1;
    if (lane == 0) { p.ml_fl()[unit] = cum_last; p.ml_al()[unit] = cum_last + gmax; }
  }
  __syncthreads();
  {
    const int t = tid >> 2, d0 = (tid & 3) * 16;
    const int sidx = c * 128 + t;
    float aq[16], ak[16];
#pragma unroll
    for (int i = 0; i < 16; ++i) { aq[i] = 0.f; ak[i] = 0.f; }
#pragma unroll
    for (int j = 0; j < 4; ++j) {
      const int ts = sidx - 3 + j;
      if (ts >= 0) {
        const float* wq = p.ml_conv + ((size_t)layer * 4 + j) * 512 + h * 64 + d0;
        const uint4 x0 = cx[j][0], x1 = cx[j][1], x2 = cx[j][2], x3 = cx[j][3];
        float f[8], wv[8];
#define LDW8(ptr) { const float4 w0_ = *(const float4*)(ptr), w1_ = *(const float4*)((ptr) + 4); wv[0] = w0_.x; wv[1] = w0_.y; wv[2] = w0_.z; wv[3] = w0_.w; wv[4] = w1_.x; wv[5] = w1_.y; wv[6] = w1_.z; wv[7] = w1_.w; }
        UNPK8(x0, f); LDW8(wq)
#pragma unroll
        for (int i = 0; i < 8; ++i) aq[i] += f[i] * wv[i];
        UNPK8(x1, f); LDW8(wq + 8)
#pragma unroll
        for (int i = 0; i < 8; ++i) aq[8 + i] += f[i] * wv[i];
        UNPK8(x2, f); LDW8(wq + 256)
#pragma unroll
        for (int i = 0; i < 8; ++i) ak[i] += f[i] * wv[i];
        UNPK8(x3, f); LDW8(wq + 264)
#pragma unroll
        for (int i = 0; i < 8; ++i) ak[8 + i] += f[i] * wv[i];
#undef LDW8
      }
    }
    const float pet = pe[t];
#pragma unroll
    for (int i = 0; i < 16; ++i) {
      aq[i] = silu(aq[i]);
      ak[i] = silu(ak[i]) * 0.125f;
    }
#pragma unroll
    for (int i = 0; i < 16; ++i) KxT[(d0 + i) * 136 + t] = f2bf(pet * ak[i]);
    bf16* dq = p.mlqk() + TROW(t) * 512 + h * 128 + d0;
    uint4 o;
    o.x = pk2(aq[0], aq[1]); o.y = pk2(aq[2], aq[3]); o.z = pk2(aq[4], aq[5]); o.w = pk2(aq[6], aq[7]);
    *(uint4*)dq = o;
    o.x = pk2(aq[8], aq[9]); o.y = pk2(aq[10], aq[11]); o.z = pk2(aq[12], aq[13]); o.w = pk2(aq[14], aq[15]);
    *(uint4*)(dq + 8) = o;
    o.x = pk2(ak[0], ak[1]); o.y = pk2(ak[2], ak[3]); o.z = pk2(ak[4], ak[5]); o.w = pk2(ak[6], ak[7]);
    *(uint4*)(dq + 64) = o;
    o.x = pk2(ak[8], ak[9]); o.y = pk2(ak[10], ak[11]); o.z = pk2(ak[12], ak[13]); o.w = pk2(ak[14], ak[15]);
    *(uint4*)(dq + 72) = o;
    load_vxT(p.U() + C_MV + h * 64, VxT, c, rbase, rpad);
    if (tid < 128) {
      VxT[64 * 136 + tid] = (bf16)0x3F80;
#pragma unroll
      for (int i = 65; i < 80; ++i) VxT[i * 136 + tid] = 0;
    }
  }
  __syncthreads();
  local_mfma<64, 5>(KxT, VxT, p.ml_c() + (size_t)unit * 4096, p.ml_n() + (size_t)unit * 64);
}

__device__ void ret_prep_unit(const P& p, int layer, int unit, char* smem) {
  const int tid = otid();
  const int c = unit % NCH, bh = unit / NCH, h = bh & 3, b = bh >> 2;
  bf16* KxT = (bf16*)smem;
  bf16* VxT = KxT + 64 * 136;
  const int rbase = b * RB + c * 128 - PADB, rpad = RREAL + b * PADB;
  const float l2g = __log2f(1.f - exp2f(-5.f - (float)h));
  __syncthreads();
  {
    const int t = tid >> 2, i0 = (tid & 3) * 8;
    const int sidx = c * 128 + t;
    const float4 ca = *(const float4*)(p.rope_cos() + sidx * 32 + i0), cb = *(const float4*)(p.rope_cos() + sidx * 32 + i0 + 4);
    const float4 sa = *(const float4*)(p.rope_sin() + sidx * 32 + i0), sb = *(const float4*)(p.rope_sin() + sidx * 32 + i0 + 4);
    const float cs[8] = {ca.x, ca.y, ca.z, ca.w, cb.x, cb.y, cb.z, cb.w};
    const float sn[8] = {sa.x, sa.y, sa.z, sa.w, sb.x, sb.y, sb.z, sb.w};
    bf16* qp = p.U() + TROW(t) * US + C_RQ + h * 64 + i0;
    bf16* kp = p.U() + TROW(t) * US + C_RK + h * 64 + i0;
    const uint4 q1 = *(const uint4*)qp, q2 = *(const uint4*)(qp + 32), k1 = *(const uint4*)kp, k2 = *(const uint4*)(kp + 32);
    float a[8], bb[8], o1[8], o2[8];
    UNPK8(q1, a); UNPK8(q2, bb);
#pragma unroll
    for (int i = 0; i < 8; ++i) { o1[i] = a[i] * cs[i] - bb[i] * sn[i]; o2[i] = a[i] * sn[i] + bb[i] * cs[i]; }
    uint4 o;
    o.x = pk2(o1[0], o1[1]); o.y = pk2(o1[2], o1[3]); o.z = pk2(o1[4], o1[5]); o.w = pk2(o1[6], o1[7]);
    *(uint4*)qp = o;
    o.x = pk2(o2[0], o2[1]); o.y = pk2(o2[2], o2[3]); o.z = pk2(o2[4], o2[5]); o.w = pk2(o2[6], o2[7]);
    *(uint4*)(qp + 32) = o;
    UNPK8(k1, a); UNPK8(k2, bb);
    const float kdec = exp2f((float)(127 - t) * l2g);
#pragma unroll
    for (int i = 0; i < 8; ++i) {
      o1[i] = (a[i] * cs[i] - bb[i] * sn[i]) * 0.125f; o2[i] = (a[i] * sn[i] + bb[i] * cs[i]) * 0.125f;
    }
#pragma unroll
    for (int i = 0; i < 8; ++i) { KxT[(i0 + i) * 136 + t] = f2bf(o1[i] * kdec); KxT[(32 + i0 + i) * 136 + t] = f2bf(o2[i] * kdec); }
    o.x = pk2(o1[0], o1[1]); o.y = pk2(o1[2], o1[3]); o.z = pk2(o1[4], o1[5]); o.w = pk2(o1[6], o1[7]);
    *(uint4*)kp = o;
    o.x = pk2(o2[0], o2[1]); o.y = pk2(o2[2], o2[3]); o.z = pk2(o2[4], o2[5]); o.w = pk2(o2[6], o2[7]);
    *(uint4*)(kp + 32) = o;
    load_vxT(p.U() + C_RV + h * 64, VxT, c, rbase, rpad);
  }
  __syncthreads();
  local_mfma<64, 4>(KxT, VxT, p.ret_loc() + (size_t)unit * 4096, nullptr);
}

__device__ void phase_scan(const P& p) {
  const int g = blockIdx.x * NT + otid();
  constexpr int N_GLA = 8 * 2048, N_ML = 8 * 4160, N_RET = 8 * 4096;
  constexpr int SB_ = 13, NBAT = NCH / SB_;
  if (g < N_GLA) {
    const int bh = g / 2048, de = g % 2048, d = de >> 6;
    float* base = p.gla_loc() + (size_t)bh * NCH * 2048 + de;
    const float* db = p.gla_dec() + (size_t)bh * NCH * 32 + d;
    float st = 0.f;
#pragma unroll 1
    for (int bt = 0; bt < NBAT; ++bt) {
      float loc[SB_], dec[SB_];
#pragma unroll
      for (int n = 0; n < SB_; ++n) { loc[n] = base[(size_t)n * 2048]; dec[n] = db[n * 32]; }
#pragma unroll
      for (int n = 0; n < SB_; ++n) { base[(size_t)n * 2048] = st; st = dec[n] * st + loc[n]; }
      base += (size_t)SB_ * 2048; db += SB_ * 32;
    }
  } else if (g < N_GLA + N_ML) {
    const int gg = g - N_GLA;
    const int bh = gg / 4160, idx = gg % 4160;
    float* base = (idx < 4096) ? (p.ml_c() + (size_t)bh * NCH * 4096 + idx) : (p.ml_n() + (size_t)bh * NCH * 64 + (idx - 4096));
    const int stride = (idx < 4096) ? 4096 : 64;
    float st = 0.f, m = 0.f;
    int unit = bh * NCH;
#pragma unroll 1
    for (int bt = 0; bt < NBAT; ++bt) {
      float loc[SB_], fl[SB_], al[SB_];
#pragma unroll
      for (int n = 0; n < SB_; ++n) { loc[n] = base[(size_t)n * stride]; fl[n] = p.ml_fl()[unit + n]; al[n] = p.ml_al()[unit + n]; }
#pragma unroll
      for (int n = 0; n < SB_; ++n) {
        const float mn = fmaxf(fl[n] + m, al[n]);
        const float sp = __expf(fl[n] + m - mn), sl = __expf(al[n] - mn);
        base[(size_t)n * stride] = st;
        st = sp * st + sl * loc[n];
        if (idx == 0) p.ml_mprev()[unit + n] = m;
        m = mn;
      }
      base += (size_t)SB_ * stride; unit += SB_;
    }
  } else if (g < N_GLA + N_ML + N_RET) {
    const int gg = g - N_GLA - N_ML;
    const int bh = gg / 4096, de = gg % 4096, h = bh & 3;
    const float dec = exp2f(128.f * __log2f(1.f - exp2f(-5.f - (float)h)));
    float* base = p.ret_loc() + (size_t)bh * NCH * 4096 + de;
    float st = 0.f;
#pragma unroll 1
    for (int bt = 0; bt < NBAT; ++bt) {
      float loc[SB_];
#pragma unroll
      for (int n = 0; n < SB_; ++n) loc[n] = base[(size_t)n * 4096];
#pragma unroll
      for (int n = 0; n < SB_; ++n) { base[(size_t)n * 4096] = st; st = dec * st + loc[n]; }
      base += (size_t)SB_ * 4096;
    }
  }
}

template <int MX>
__device__ void out_unit(const P& p, int layer, int unit, char* smem) {
  constexpr int DK = (MX == 0) ? 32 : 64;
  constexpr int NE = (MX == 1) ? 5 : 4;
  const int tid = otid(), lane = tid & 63, w = tid >> 6, r = lane & 15, q4 = lane >> 4;
  const int c = unit % NCH, bh = unit / NCH, h = bh & 3, b = bh >> 2;
  bf16* Qs = (bf16*)smem;
  bf16* Ks = Qs + 128 * 72;
  bf16* Vt = Ks + 128 * 72;
  bf16* Ss = Vt + 80 * 136;
  bf16* St = Ss + 128 * 136;
  float* va = (float*)(St + 80 * 72);
  float* vb = va + 128;
  float* vc = vb + 128;
  const int rbase = b * RB + c * 128 - PADB, rpad = RREAL + b * PADB;
  const float l2g = __log2f(1.f - exp2f(-5.f - (float)h));
  float mprev = 0.f;
  constexpr int GC = (MX == 0) ? C_GR : (MX == 1 ? C_MO : C_RG);
  uint2 gpre[4];
  {
    const bf16* gp = p.U() + TROW(16 * w + r) * US + GC + h * 64 + 4 * q4;
#pragma unroll
    for (int et = 0; et < 4; ++et) gpre[et] = *(const uint2*)(gp + 16 * et);
  }
  __syncthreads();
  {
    const int t = tid >> 2;
    if (MX == 0) {
      const int d0 = (tid & 3) * 8;
      *(uint4*)(Qs + t * 72 + d0) = *(const uint4*)(p.U() + TROW(t) * US + C_GQ + h * 32 + d0);
      *(uint4*)(Ks + t * 72 + d0) = *(const uint4*)(p.U() + TROW(t) * US + C_GK + h * 32 + d0);
    } else {
      const int d0 = (tid & 3) * 16;
      const bf16* qs = (MX == 1) ? (p.mlqk() + TROW(t) * 512 + h * 128 + d0) : (p.U() + TROW(t) * US + C_RQ + h * 64 + d0);
      const bf16* ks = (MX == 1) ? (p.mlqk() + TROW(t) * 512 + h * 128 + 64 + d0) : (p.U() + TROW(t) * US + C_RK + h * 64 + d0);
      *(uint4*)(Qs + t * 72 + d0) = *(const uint4*)qs;
      *(uint4*)(Qs + t * 72 + d0 + 8) = *(const uint4*)(qs + 8);
      *(uint4*)(Ks + t * 72 + d0) = *(const uint4*)ks;
      *(uint4*)(Ks + t * 72 + d0 + 8) = *(const uint4*)(ks + 8);
    }
    {
      const int e0 = (tid >> 7) * 16;
      const int t = tid & 127;
      constexpr int VC = (MX == 0) ? C_GV : (MX == 1 ? C_MV : C_RV);
      const bf16* vs = p.U() + TROW(t) * US + VC + h * 64 + e0;
      const uint4 v0 = *(const uint4*)vs, v1 = *(const uint4*)(vs + 8);
      Vt[(e0 + 0) * 136 + t] = (bf16)(v0.x & 0xffffu); Vt[(e0 + 1) * 136 + t] = (bf16)(v0.x >> 16);
      Vt[(e0 + 2) * 136 + t] = (bf16)(v0.y & 0xffffu); Vt[(e0 + 3) * 136 + t] = (bf16)(v0.y >> 16);
      Vt[(e0 + 4) * 136 + t] = (bf16)(v0.z & 0xffffu); Vt[(e0 + 5) * 136 + t] = (bf16)(v0.z >> 16);
      Vt[(e0 + 6) * 136 + t] = (bf16)(v0.w & 0xffffu); Vt[(e0 + 7) * 136 + t] = (bf16)(v0.w >> 16);
      Vt[(e0 + 8) * 136 + t] = (bf16)(v1.x & 0xffffu); Vt[(e0 + 9) * 136 + t] = (bf16)(v1.x >> 16);
      Vt[(e0 + 10) * 136 + t] = (bf16)(v1.y & 0xffffu); Vt[(e0 + 11) * 136 + t] = (bf16)(v1.y >> 16);
      Vt[(e0 + 12) * 136 + t] = (bf16)(v1.z & 0xffffu); Vt[(e0 + 13) * 136 + t] = (bf16)(v1.z >> 16);
      Vt[(e0 + 14) * 136 + t] = (bf16)(v1.w & 0xffffu); Vt[(e0 + 15) * 136 + t] = (bf16)(v1.w >> 16);
    }
    if (MX == 0) {
      const int d = tid & 31, e0 = (tid >> 5) * 4;
      const float4 s4 = *(const float4*)(p.gla_loc() + ((size_t)unit * 32 + d) * 64 + e0);
      St[(e0 + 0) * 72 + d] = f2bf(s4.x); St[(e0 + 1) * 72 + d] = f2bf(s4.y); St[(e0 + 2) * 72 + d] = f2bf(s4.z); St[(e0 + 3) * 72 + d] = f2bf(s4.w);
    } else {
      const int d = tid & 63, e0 = (tid >> 6) * 8;
      const float* sp = ((MX == 1) ? p.ml_c() : p.ret_loc()) + ((size_t)unit * 64 + d) * 64 + e0;
      const float4 s4 = *(const float4*)sp, s5 = *(const float4*)(sp + 4);
      St[(e0 + 0) * 72 + d] = f2bf(s4.x); St[(e0 + 1) * 72 + d] = f2bf(s4.y); St[(e0 + 2) * 72 + d] = f2bf(s4.z); St[(e0 + 3) * 72 + d] = f2bf(s4.w);
      St[(e0 + 4) * 72 + d] = f2bf(s5.x); St[(e0 + 5) * 72 + d] = f2bf(s5.y); St[(e0 + 6) * 72 + d] = f2bf(s5.z); St[(e0 + 7) * 72 + d] = f2bf(s5.w);
    }
    if (MX == 1) {
      mprev = p.ml_mprev()[unit];
      if (tid < 128) {
        const float g = p.ml_g()[TROW(tid) * 4 + h], pm = p.ml_pm()[TROW(tid) * 4 + h], cf = p.ml_cf()[TROW(tid) * 4 + h];
        va[tid] = fmaxf(mprev, pm); vb[tid] = g; vc[tid] = cf;
        Vt[64 * 136 + tid] = (bf16)0x3F80;
#pragma unroll
        for (int i = 65; i < 80; ++i) Vt[i * 136 + tid] = 0;
      }
      if (tid < 64) {
        St[64 * 72 + tid] = f2bf(p.ml_n()[(size_t)unit * 64 + tid]);
#pragma unroll
        for (int i = 65; i < 80; ++i) St[i * 72 + tid] = 0;
      }
    }
  }
  __syncthreads();
  const int ktmax = w | 1;
#pragma unroll
  for (int kt = 0; kt < 8; ++kt) {
    if (kt <= ktmax) {
      f32x4 s = f32x4{0.f, 0.f, 0.f, 0.f};
#pragma unroll
      for (int kb = 0; kb < DK / 32; ++kb) {
        const bf16x8 a = *(const bf16x8*)(Qs + (16 * w + r) * 72 + kb * 32 + q4 * 8);
        const bf16x8 bq = *(const bf16x8*)(Ks + (16 * kt + r) * 72 + kb * 32 + q4 * 8);
        s = MFMA(bq, a, s);
      }
      const int qq = 16 * w + r;
      const float vaq = (MX == 1) ? va[qq] : 0.f;
      float sw[4];
#pragma unroll
      for (int j = 0; j < 4; ++j) {
        const int kk = 16 * kt + 4 * q4 + j;
        float wgt = 0.f;
        if (kk <= qq) {
          if (MX == 0) wgt = 1.f;
          else if (MX == 1) wgt = __expf(vb[kk] - vaq);
          else wgt = exp2f((float)(qq - kk) * l2g);
        }
        sw[j] = s[j] * wgt;
      }
      uint2 so; so.x = pk2(sw[0], sw[1]); so.y = pk2(sw[2], sw[3]);
      *(uint2*)(Ss + qq * 136 + 16 * kt + 4 * q4) = so;
    }
  }
  __syncthreads();
  f32x4 o[NE], o2[NE];
#pragma unroll
  for (int et = 0; et < NE; ++et) { o[et] = f32x4{0.f, 0.f, 0.f, 0.f}; o2[et] = f32x4{0.f, 0.f, 0.f, 0.f}; }
  const int kend = 16 * (ktmax + 1);
  for (int k0 = 0; k0 < kend; k0 += 32) {
    const bf16x8 a = *(const bf16x8*)(Ss + (16 * w + r) * 136 + k0 + q4 * 8);
#pragma unroll
    for (int et = 0; et < NE; ++et) {
      const bf16x8 bv = *(const bf16x8*)(Vt + (16 * et + r) * 136 + k0 + q4 * 8);
      o[et] = MFMA(bv, a, o[et]);
    }
  }
#pragma unroll
  for (int kb = 0; kb < DK / 32; ++kb) {
    const bf16x8 a = *(const bf16x8*)(Qs + (16 * w + r) * 72 + kb * 32 + q4 * 8);
#pragma unroll
    for (int et = 0; et < NE; ++et) {
      const bf16x8 bs = *(const bf16x8*)(St + (16 * et + r) * 72 + kb * 32 + q4 * 8);
      o2[et] = MFMA(bs, a, o2[et]);
    }
  }
  const float* ng = ((MX == 0) ? p.gla_norm : (MX == 1 ? p.ml_norm : p.ret_norm)) + layer * 256 + h * 64 + 4 * q4;
  {
    const int qq = 16 * w + r;
    float rsc = 1.f;
    if (MX == 1) rsc = __expf(mprev - va[qq]);
    if (MX == 2) rsc = exp2f((float)(qq + 1) * l2g);
    f32x4 ov[4];
#pragma unroll
    for (int et = 0; et < 4; ++et) ov[et] = o[et] + o2[et] * rsc;
    if (MX == 1) {
      float den = o[NE - 1][0] + rsc * o2[NE - 1][0];
      den = __shfl(den, r);
      const float fl = __expf(-(vc[qq] + va[qq]));
      const float inv = 1.f / fmaxf(fabsf(den), fl);
#pragma unroll
      for (int et = 0; et < 4; ++et) ov[et] = ov[et] * inv;
    }
    float ss = 0.f;
#pragma unroll
    for (int et = 0; et < 4; ++et) ss += ov[et][0] * ov[et][0] + ov[et][1] * ov[et][1] + ov[et][2] * ov[et][2] + ov[et][3] * ov[et][3];
    ss += __shfl_xor(ss, 16); ss += __shfl_xor(ss, 32);
    const float rms = rsqrtf(ss * (1.f / 64.f) + EPS);
    bf16* yp = p.y() + TROW(qq) * D + (MX + 1) * 256 + h * 64 + 4 * q4;
#pragma unroll
    for (int et = 0; et < 4; ++et) {
      const float4 g4 = *(const float4*)(ng + 16 * et);
      const float t0 = lo16(gpre[et].x), t1 = hi16(gpre[et].x), t2 = lo16(gpre[et].y), t3 = hi16(gpre[et].y);
      const float a0 = (MX == 1) ? sigm(t0) : silu(t0), a1 = (MX == 1) ? sigm(t1) : silu(t1), a2 = (MX == 1) ? sigm(t2) : silu(t2), a3 = (MX == 1) ? sigm(t3) : silu(t3);
      uint2 ov2;
      ov2.x = pk2(ov[et][0] * rms * g4.x * a0, ov[et][1] * rms * g4.y * a1);
      ov2.y = pk2(ov[et][2] * rms * g4.z * a2, ov[et][3] * rms * g4.w * a3);
      *(uint2*)(yp + 16 * et) = ov2;
    }
  }

}

#define XB_TMO      128
#define XB_XCNT(j)  (256  + 64 * (j))
#define XB_XSUB(j)  (1280 + 64 * (j))
#define XB_XGEN(j)  (2304 + 64 * (j))
#define XB_TOP      3328
#define XB_TOPGEN   3392
#define XCD_BAR_WORDS 3456
#define XB_SPIN_CAP (1u << 18)
#define XLAS __attribute__((address_space(3)))

__device__ __forceinline__ unsigned xb_ld(unsigned* p)              { return __hip_atomic_load(p, __ATOMIC_RELAXED, __HIP_MEMORY_SCOPE_AGENT); }
__device__ __forceinline__ unsigned xb_add(unsigned* p, unsigned v) { return __hip_atomic_fetch_add(p, v, __ATOMIC_RELAXED, __HIP_MEMORY_SCOPE_AGENT); }
__device__ __forceinline__ unsigned xb_xcc_id() { return (unsigned)__builtin_amdgcn_s_getreg((3 << 11) | 20) & 0xFu; }
#define XB_SPIN(cond, bar) do { unsigned _sp = 0; while (cond) { __builtin_amdgcn_s_sleep(1); \
    if ((++_sp & 255u) == 0u) { if (xb_ld(&(bar)[XB_TMO])) break; if (_sp > XB_SPIN_CAP) { atomicAdd(&(bar)[XB_TMO], 1u); break; } } } } while (0)

struct XcdBarrier {
    unsigned* bar; unsigned x;
    volatile XLAS unsigned* st;
};

__device__ __forceinline__ XcdBarrier xcd_barrier_post(unsigned* bar, volatile XLAS unsigned* st) {
    XcdBarrier b; b.bar = bar; b.x = xb_xcc_id(); b.st = st;
    if (threadIdx.x == 0) (void)xb_add(&bar[XB_XCNT(b.x)], 1u);
    return b;
}
__device__ __forceinline__ void xcd_barrier_complete(unsigned* bar, unsigned x, unsigned& nloc, unsigned& nx) {
    const unsigned G = gridDim.x * gridDim.y * gridDim.z;
    unsigned sum, cnt, mine, sp = 0u;
    for (;;) {
        sum = 0u; cnt = 0u; mine = 0u;
#pragma unroll
        for (unsigned j = 0; j < 16; ++j) { const unsigned c = xb_ld(&bar[XB_XCNT(j)]); sum += c; cnt += (c > 0u) ? 1u : 0u; mine = (j == x) ? c : mine; }
        if (sum == G) break;
        __builtin_amdgcn_s_sleep(1);
        if ((++sp & 255u) == 0u) { if (xb_ld(&bar[XB_TMO])) break; if (sp > XB_SPIN_CAP) { atomicAdd(&bar[XB_TMO], 1u); break; } }
    }
    nloc = mine > 0u ? mine : 1u; nx = cnt > 0u ? cnt : 1u;
}

__device__ __forceinline__ void xcd_barrier(const XcdBarrier& b) {
    asm volatile("s_waitcnt vmcnt(0)" ::: "memory");
    __syncthreads();
    if (threadIdx.x == 0) {
        unsigned* bar = b.bar;
        __builtin_amdgcn_s_waitcnt(0);
        unsigned nloc = b.st[0], nx = b.st[1];
        if (nloc == 0u) { xcd_barrier_complete(bar, b.x, nloc, nx); b.st[0] = nloc; b.st[1] = nx; }
        const unsigned old = xb_add(&bar[XB_XSUB(b.x)], 1u);
        const unsigned gen = old / nloc;
        if (old + 1u == (gen + 1u) * nloc) {
            __builtin_amdgcn_fence(__ATOMIC_RELEASE, "agent");
            asm volatile("s_waitcnt vmcnt(0)" ::: "memory");
            const unsigned og = xb_add(&bar[XB_TOP], 1u);
            const unsigned tg = og / nx;
            if (og + 1u == (tg + 1u) * nx) xb_add(&bar[XB_TOPGEN], 1u);
            else XB_SPIN(xb_ld(&bar[XB_TOPGEN]) == tg, bar);
            __builtin_amdgcn_fence(__ATOMIC_ACQUIRE, "agent");
            xb_add(&bar[XB_XGEN(b.x)], 1u);
            asm volatile("s_waitcnt vmcnt(0)" ::: "memory");
        } else {
            XB_SPIN(xb_ld(&bar[XB_XGEN(b.x)]) == gen, bar);
            __builtin_amdgcn_fence(__ATOMIC_ACQUIRE, "agent");
            asm volatile("s_waitcnt vmcnt(0)" ::: "memory");
        }
    }
    __syncthreads();
}


__global__ void __launch_bounds__(NT) mega(P p) {
  extern __shared__ __attribute__((aligned(16))) char smem[];
  cg::grid_group grid = cg::this_grid();
  volatile XLAS unsigned* xst = (volatile XLAS unsigned*)(smem + LDS_MAIN);
  if (threadIdx.x == 0) { xst[0] = 0u; xst[1] = 0u; }
  __syncthreads();
  (void)xcd_barrier_post(p.bar(), xst);
#define GRID_BAR() do { XcdBarrier xb_; xb_.bar = p.bar(); xb_.x = xb_xcc_id(); xb_.st = xst; xcd_barrier(xb_); } while (0)
  phase_init_rows(p);
  phase_rope(p);
  phase_cvt(p, -1, 0, smem);
  if (gridDim.y == 12345u) grid.sync();
  GRID_BAR();
  for (int layer = 0; layer < DEPTH; ++layer) {
    { EpiU e; e.O = p.U(); fast_gemm(smem, p.xn(), p.Win_t(), MROWS, NPAD_IN, D, e); }
    GRID_BAR();
    for (int u = blockIdx.x; u < SB_M1 + 3 * NUNIT; u += gridDim.x) {
      if (u < SB_M1) sb_unit(p, u, smem);
      else {
        const int v = u - SB_M1, kind = v / NUNIT, uu = v % NUNIT;
        if (kind == 0) gla_prep_unit(p, layer, uu, smem);
        else if (kind == 1) ml_prep_unit(p, layer, uu, smem);
        else ret_prep_unit(p, layer, uu, smem);
      }
    }
    GRID_BAR();
    phase_scan(p);
    phase_cvt(p, layer, (layer + 1 < DEPTH) ? layer + 1 : -1, smem);
    GRID_BAR();
    for (int u = blockIdx.x; u < 3 * NUNIT + (NUNIT - SB_M1); u += gridDim.x) {
      if (u >= 3 * NUNIT) { sb_unit(p, SB_M1 + (u - 3 * NUNIT), smem); continue; }
      const int kind = u / NUNIT, uu = u % NUNIT;
      if (kind == 0) out_unit<0>(p, layer, uu, smem);
      else if (kind == 1) out_unit<1>(p, layer, uu, smem);
      else out_unit<2>(p, layer, uu, smem);
    }
    GRID_BAR();
    phase_gemm_merge(p, layer, (bf16*)smem);
    { const int bb_ = obid(); if (bb_ < 32) left_merge(p, layer, bb_, smem); }
    GRID_BAR();
    {
      EpiFused<false> e; e.h = p.h(); e.out = p.out; e.xn = p.xn(); e.gpost = p.g_mix_post + layer * D; e.gnext = p.g_ffn_pre + layer * D;
      e.ex1 = p.ex1(); e.ex2 = p.ex2(); e.cnt1 = p.cnt() + (layer * 4 + 0) * 64; e.cnt2 = p.cnt() + (layer * 4 + 1) * 64;
      fast_gemm(smem, p.xn(), p.Wo_t(), LROW0, D, D, e);
    }
    { const int bb_ = obid(); if (bb_ < 32) left_gemm_f32(p.xn(), D, p.Wo_t(), D, bb_, p.tmp(), smem); }
    GRID_BAR();
    phase_norm(p, p.g_mix_post + layer * D, p.g_ffn_pre + layer * D, false, LROW0, RREAL);
    GRID_BAR();
    { EpiGU e; e.O = p.act(); fast_gemm(smem, p.xn(), p.Wgu_t(), MROWS, 2 * FF, D, e); }
    GRID_BAR();
    const bool last = (layer == DEPTH - 1);
    const float* gnx = p.g_mix_pre + (last ? layer : layer + 1) * D;
    if (!last) {
      EpiFused<false> e; e.h = p.h(); e.out = p.out; e.xn = p.xn(); e.gpost = p.g_ffn_post + layer * D; e.gnext = gnx;
      e.ex1 = p.ex1(); e.ex2 = p.ex2(); e.cnt1 = p.cnt() + (layer * 4 + 2) * 64; e.cnt2 = p.cnt() + (layer * 4 + 3) * 64;
      fast_gemm(smem, p.act(), p.Wd_t(), LROW0, D, FF, e);
    } else {
      EpiFused<true> e; e.h = p.h(); e.out = p.out; e.xn = p.xn(); e.gpost = p.g_ffn_post + layer * D; e.gnext = gnx;
      e.ex1 = p.ex1(); e.ex2 = p.ex2(); e.cnt1 = p.cnt() + (layer * 4 + 2) * 64; e.cnt2 = p.cnt() + (layer * 4 + 3) * 64;
      fast_gemm(smem, p.act(), p.Wd_t(), LROW0, D, FF, e);
    }
    { const int bb_ = obid(); if (bb_ < 32) left_gemm_f32(p.act(), FF, p.Wd_t(), FF, bb_, p.tmp(), smem); }
    GRID_BAR();
    phase_norm(p, p.g_ffn_post + layer * D, gnx, last, LROW0, RREAL);
    if (!last) GRID_BAR();
  }
}

extern "C" void kernel_launch(void* const* d_in, const int* in_sizes, int n_in, void* d_out, int out_size, void* d_ws,
                              size_t ws_size, hipStream_t stream) {
  static int grid_blocks = 0;
  if (!grid_blocks) {
    int dev = 0, cus = 0, per_cu = 0;
    hipGetDevice(&dev);
    hipDeviceGetAttribute(&cus, hipDeviceAttributeMultiprocessorCount, dev);
    hipFuncSetAttribute((const void*)mega, hipFuncAttributeMaxDynamicSharedMemorySize, LDS_BYTES);
    hipOccupancyMaxActiveBlocksPerMultiprocessor(&per_cu, (const void*)mega, NT, LDS_BYTES);
    if (per_cu < 1) per_cu = 1;
    grid_blocks = cus * per_cu;
  }
  P p{};
  const float* const* in = (const float* const*)d_in;
  p.x = in[0]; p.meta = in[1]; p.g_mix_pre = in[2]; p.g_mix_post = in[3]; p.g_ffn_pre = in[4]; p.g_ffn_post = in[5];
  p.w_in = in[6]; p.gla_wg = in[7]; p.gla_bg = in[8]; p.gla_norm = in[9]; p.ml_conv = in[10]; p.ml_bi = in[11];
  p.ml_bf = in[12]; p.ml_norm = in[13]; p.ret_norm = in[14]; p.w_branch = in[15]; p.b_merge = in[16]; p.w_out = in[17];
  p.w_gate = in[18]; p.w_up = in[19]; p.w_down = in[20];
  p.out = (float*)d_out;
  p.ws = (char*)d_ws;
  if (WS_TOTAL > ws_size) { fprintf(stderr, "kernel_launch: workspace too small: need %zu have %zu\n", (size_t)WS_TOTAL, ws_size); return; }
  if (hipMemsetAsync(p.ws + OFF_bar, 0, (size_t)(3456 + 1024) * 4, stream) != hipSuccess) { fprintf(stderr, "kernel_launch: memset of barrier words failed\n"); return; }
  void* args[] = {&p};
  hipError_t e = hipLaunchCooperativeKernel((const void*)mega, dim3(grid_blocks), dim3(NT), args, LDS_BYTES, stream);
  if (e != hipSuccess) fprintf(stderr, "cooperative launch failed: %s (grid %d)\n", hipGetErrorString(e), grid_blocks);
}
```
